# Optimizing an MI355X kernel written in HIP

```python
import math
import jax, jax.numpy as jnp
from jax import lax
import numpy as np

D_MODEL = 2048
BATCH = 1
SEQ = 16384
DEPTH = 2

SSM_WIDTH = D_MODEL // 2
SSM_GROUP = 16
SSM_GROUPS = SSM_WIDTH // SSM_GROUP
SSM_STATE = 64
HEAD_DIM = 64
ATT_HEADS = D_MODEL // (2 * HEAD_DIM)
ATT_KV_HEADS = ATT_HEADS // 4
ATT_GROUP = ATT_HEADS // ATT_KV_HEADS
ATT_Q_WIDTH = ATT_HEADS * HEAD_DIM
ATT_KV_WIDTH = ATT_KV_HEADS * HEAD_DIM
WINDOW = 128
ATT_BLOCK = 128
ROPE_THETA = 10000.0
GLA_HEADS = 4
GLA_V_WIDTH = D_MODEL // 2
GLA_DV = GLA_V_WIDTH // GLA_HEADS
GLA_DK = GLA_DV // 2
GLA_QK_WIDTH = GLA_HEADS * GLA_DK
GLA_GATE_RANK = 16
GLA_TAU = 16.0
GLA_CHUNK = 64
D_FF = 4 * D_MODEL
EPS = 1e-6
IN_WIDTH = (SSM_WIDTH + ATT_Q_WIDTH + 2 * ATT_KV_WIDTH + 2 * GLA_QK_WIDTH + GLA_V_WIDTH
            + GLA_GATE_RANK + GLA_V_WIDTH + 3 * D_MODEL)

kernel_name = "hybrid_s5_swa_gla_gated_block"


def _split_points():
    sizes = [SSM_WIDTH, ATT_Q_WIDTH, ATT_KV_WIDTH, ATT_KV_WIDTH, GLA_QK_WIDTH, GLA_QK_WIDTH,
             GLA_V_WIDTH, GLA_GATE_RANK, GLA_V_WIDTH, 3 * D_MODEL]
    return [int(v) for v in np.cumsum(sizes)[:-1]]


def rms_norm(x, g):
    xf = x.astype(jnp.float32)
    y = xf * lax.rsqrt(jnp.mean(xf * xf, axis=-1, keepdims=True) + EPS)
    return (y * g.astype(jnp.float32)).astype(x.dtype)


def rope(x, pos):
    half = HEAD_DIM // 2
    inv = ROPE_THETA ** (-jnp.arange(half, dtype=jnp.float32) / half)
    ang = pos.astype(jnp.float32)[:, None] * inv[None, :]
    cos = jnp.cos(ang)[None, :, None, :]
    sin = jnp.sin(ang)[None, :, None, :]
    xf = x.astype(jnp.float32)
    x1, x2 = xf[..., :half], xf[..., half:]
    return jnp.concatenate([x1 * cos - x2 * sin, x2 * cos + x1 * sin], axis=-1).astype(x.dtype)


def _cplx_combine(e1, e2):
    a1r, a1i, b1r, b1i = e1
    a2r, a2i, b2r, b2i = e2
    return (a2r * a1r - a2i * a1i,
            a2r * a1i + a2i * a1r,
            a2r * b1r - a2i * b1i + b2r,
            a2r * b1i + a2i * b1r + b2i)


def s5_branch(u, lam_re, lam_im, log_step, b_re, b_im, c_re, c_im, d_skip, w_glu, b_glu):
    bsz, s_len, _ = u.shape
    uf = u.astype(jnp.float32)
    ug = uf.reshape(bsz, s_len, SSM_GROUPS, SSM_GROUP)
    step = jnp.exp(log_step.astype(jnp.float32))[:, None]
    lr = lam_re.astype(jnp.float32)
    li = lam_im.astype(jnp.float32)
    mag = jnp.exp(lr * step)
    ar = mag * jnp.cos(li * step)
    ai = mag * jnp.sin(li * step)
    den = lr * lr + li * li
    fr = ((ar - 1.0) * lr + ai * li) / den
    fi = (ai * lr - (ar - 1.0) * li) / den
    br = b_re.astype(jnp.float32)
    bi = b_im.astype(jnp.float32)
    bbr = fr[..., None] * br - fi[..., None] * bi
    bbi = fr[..., None] * bi + fi[..., None] * br
    xr = jnp.einsum('bsgc,gpc->sbgp', ug, bbr)
    xi = jnp.einsum('bsgc,gpc->sbgp', ug, bbi)
    a_r = jnp.broadcast_to(ar[None, None], xr.shape)
    a_i = jnp.broadcast_to(ai[None, None], xr.shape)
    _, _, hr, hi = lax.associative_scan(_cplx_combine, (a_r, a_i, xr, xi), axis=0)
    y = (jnp.einsum('sbgp,gcp->bsgc', hr, c_re.astype(jnp.float32))
         - jnp.einsum('sbgp,gcp->bsgc', hi, c_im.astype(jnp.float32)))
    y = y.reshape(bsz, s_len, SSM_WIDTH) + d_skip.astype(jnp.float32) * uf
    z = jax.nn.gelu(y)
    z = z * jax.nn.sigmoid(z @ w_glu.astype(jnp.float32) + b_glu.astype(jnp.float32))
    return z.astype(u.dtype)


def swa_branch(q, k, v, sinks, pos):
    bsz, s_len = q.shape[:2]
    nb = s_len // ATT_BLOCK
    q = rope(q, pos)
    k = rope(k, pos)
    qb = q.reshape(bsz, nb, ATT_BLOCK, ATT_KV_HEADS, ATT_GROUP, HEAD_DIM)
    pad = ((0, 0), (ATT_BLOCK, 0), (0, 0), (0, 0))
    kp = jnp.pad(k, pad).reshape(bsz, nb + 1, ATT_BLOCK, ATT_KV_HEADS, HEAD_DIM)
    vp = jnp.pad(v, pad).reshape(bsz, nb + 1, ATT_BLOCK, ATT_KV_HEADS, HEAD_DIM)
    kb = jnp.concatenate([kp[:, :-1], kp[:, 1:]], axis=2)
    vb = jnp.concatenate([vp[:, :-1], vp[:, 1:]], axis=2)
    scores = jnp.einsum('bnqhgd,bnkhd->bnhgqk', qb, kb).astype(jnp.float32) * (HEAD_DIM ** -0.5)
    qi = jnp.arange(ATT_BLOCK)[:, None]
    kj = jnp.arange(2 * ATT_BLOCK)[None, :]
    diff = qi + ATT_BLOCK - kj
    band = (diff >= 0) & (diff < WINDOW)
    key_pos = jnp.arange(nb)[:, None] * ATT_BLOCK - ATT_BLOCK + jnp.arange(2 * ATT_BLOCK)[None, :]
    valid = band[None] & (key_pos >= 0)[:, None, :]
    scores = jnp.where(valid[None, :, None, None], scores, -jnp.inf)
    sink = sinks.astype(jnp.float32).reshape(ATT_KV_HEADS, ATT_GROUP)[None, None, :, :, None, None]
    sink = jnp.broadcast_to(sink, scores.shape[:-1] + (1,))
    probs = jax.nn.softmax(jnp.concatenate([scores, sink], axis=-1), axis=-1)[..., :-1]
    o = jnp.einsum('bnhgqk,bnkhd->bnqhgd', probs.astype(v.dtype), vb)
    return o.reshape(bsz, s_len, ATT_Q_WIDTH)


def gla_branch(q, k, v, gate_lr, out_gate, w_gate_up, b_gate, norm_g):
    bsz, s_len = q.shape[:2]
    nc = s_len // GLA_CHUNK
    f32 = jnp.float32
    log_a = jax.nn.log_sigmoid(gate_lr.astype(f32) @ w_gate_up.astype(f32) + b_gate.astype(f32)) / GLA_TAU
    shp_k = (bsz, nc, GLA_CHUNK, GLA_HEADS, GLA_DK)
    shp_v = (bsz, nc, GLA_CHUNK, GLA_HEADS, GLA_DV)
    qc = q.astype(f32).reshape(shp_k) * (GLA_DK ** -0.5)
    kc = k.astype(f32).reshape(shp_k)
    vc = v.astype(f32).reshape(shp_v)
    bcum = jnp.cumsum(log_a.reshape(shp_k), axis=2)
    b_last = bcum[:, :, -1]
    q_in = qc * jnp.exp(bcum)
    k_in = kc * jnp.exp(-bcum)
    att = jnp.einsum('bnihd,bnjhd->bnhij', q_in, k_in)
    causal = jnp.tril(jnp.ones((GLA_CHUNK, GLA_CHUNK), dtype=bool))
    att = jnp.where(causal, att, 0.0)
    o_intra = jnp.einsum('bnhij,bnjhe->bnihe', att, vc)
    k_dec = kc * jnp.exp(b_last[:, :, None] - bcum)
    upd = jnp.einsum('bnjhd,bnjhe->bnhde', k_dec, vc)
    decay = jnp.exp(b_last)

    def chunk_step(state, inp):
        u_n, g_n = inp
        return g_n[..., None] * state + u_n, state

    init = jnp.zeros((bsz, GLA_HEADS, GLA_DK, GLA_DV), f32)
    _, starts = lax.scan(chunk_step, init, (jnp.moveaxis(upd, 1, 0), jnp.moveaxis(decay, 1, 0)))
    o_inter = jnp.einsum('bnihd,nbhde->bnihe', q_in, starts)
    o = (o_intra + o_inter).reshape(bsz, s_len, GLA_HEADS, GLA_DV)
    o = o * lax.rsqrt(jnp.mean(o * o, axis=-1, keepdims=True) + EPS)
    o = o.reshape(bsz, s_len, GLA_V_WIDTH) * norm_g.astype(f32)
    o = o * jax.nn.silu(out_gate.astype(f32))
    return o.astype(q.dtype)


def setup_inputs(seed: int = 0) -> dict:
    key = jax.random.key(seed)
    ks = jax.random.split(key, 32)
    L, D = DEPTH, D_MODEL
    G, P, C = SSM_GROUPS, SSM_STATE, SSM_GROUP

    def nrm(k, shape, scale):
        return jax.random.normal(k, shape, jnp.float32) * scale

    x = nrm(ks[0], (BATCH, SEQ, D), 1.0)
    norm1_g = 1.0 + nrm(ks[1], (L, D), 0.02)
    w_in = nrm(ks[2], (L, D, IN_WIDTH), D ** -0.5)
    ssm_lam_re = -0.5 + nrm(ks[3], (L, G, P), 0.01)
    ssm_lam_im = math.pi * jnp.arange(P, dtype=jnp.float32)[None, None, :] + nrm(ks[4], (L, G, P), 0.01)
    ssm_log_step = jax.random.uniform(ks[5], (L, G), jnp.float32, math.log(1e-3), math.log(1e-1))
    ssm_b_re = nrm(ks[6], (L, G, P, C), (2.0 * C) ** -0.5)
    ssm_b_im = nrm(ks[7], (L, G, P, C), (2.0 * C) ** -0.5)
    ssm_c_re = nrm(ks[8], (L, G, C, P), (2.0 * P) ** -0.5)
    ssm_c_im = nrm(ks[9], (L, G, C, P), (2.0 * P) ** -0.5)
    ssm_d = nrm(ks[10], (L, SSM_WIDTH), 1.0)
    ssm_w_glu = nrm(ks[11], (L, SSM_WIDTH, SSM_WIDTH), SSM_WIDTH ** -0.5)
    ssm_b_glu = nrm(ks[12], (L, SSM_WIDTH), 0.02)
    att_sinks = nrm(ks[13], (L, ATT_HEADS), 0.5)
    gla_w_gate = nrm(ks[14], (L, GLA_GATE_RANK, GLA_QK_WIDTH), GLA_GATE_RANK ** -0.5)
    gla_b_gate = nrm(ks[15], (L, GLA_QK_WIDTH), 0.1)
    gla_norm_g = 1.0 + nrm(ks[16], (L, GLA_V_WIDTH), 0.02)
    w_branch_ssm = nrm(ks[17], (L, SSM_WIDTH, D), SSM_WIDTH ** -0.5)
    w_branch_att = nrm(ks[18], (L, ATT_Q_WIDTH, D), ATT_Q_WIDTH ** -0.5)
    w_branch_gla = nrm(ks[19], (L, GLA_V_WIDTH, D), GLA_V_WIDTH ** -0.5)
    w_out = nrm(ks[20], (L, D, D), D ** -0.5)
    norm2_g = 1.0 + nrm(ks[21], (L, D), 0.02)
    w_ff1 = nrm(ks[22], (L, D, D_FF), D ** -0.5)
    w_ff2 = nrm(ks[23], (L, D_FF, D), D_FF ** -0.5)
    final_norm_g = 1.0 + nrm(ks[24], (D,), 0.02)
    return {"x": x, "norm1_g": norm1_g, "w_in": w_in,
            "ssm_lam_re": ssm_lam_re, "ssm_lam_im": ssm_lam_im, "ssm_log_step": ssm_log_step,
            "ssm_b_re": ssm_b_re, "ssm_b_im": ssm_b_im, "ssm_c_re": ssm_c_re, "ssm_c_im": ssm_c_im,
            "ssm_d": ssm_d, "ssm_w_glu": ssm_w_glu, "ssm_b_glu": ssm_b_glu,
            "att_sinks": att_sinks,
            "gla_w_gate": gla_w_gate, "gla_b_gate": gla_b_gate, "gla_norm_g": gla_norm_g,
            "w_branch_ssm": w_branch_ssm, "w_branch_att": w_branch_att, "w_branch_gla": w_branch_gla,
            "w_out": w_out, "norm2_g": norm2_g, "w_ff1": w_ff1, "w_ff2": w_ff2,
            "final_norm_g": final_norm_g}


def reference(x, norm1_g, w_in, ssm_lam_re, ssm_lam_im, ssm_log_step, ssm_b_re, ssm_b_im,
              ssm_c_re, ssm_c_im, ssm_d, ssm_w_glu, ssm_b_glu, att_sinks, gla_w_gate, gla_b_gate,
              gla_norm_g, w_branch_ssm, w_branch_att, w_branch_gla, w_out, norm2_g, w_ff1, w_ff2,
              final_norm_g):
    bsz, s_len, _ = x.shape
    pos = jnp.arange(s_len, dtype=jnp.int32)
    splits = _split_points()
    for l in range(DEPTH):
        h = rms_norm(x, norm1_g[l])
        proj = h @ w_in[l]
        (u_ssm, aq, ak, av, gq, gk, gv, g_lr, g_out, merge) = jnp.split(proj, splits, axis=-1)
        y_ssm = s5_branch(u_ssm, ssm_lam_re[l], ssm_lam_im[l], ssm_log_step[l], ssm_b_re[l],
                          ssm_b_im[l], ssm_c_re[l], ssm_c_im[l], ssm_d[l], ssm_w_glu[l], ssm_b_glu[l])
        y_att = swa_branch(aq.reshape(bsz, s_len, ATT_HEADS, HEAD_DIM),
                           ak.reshape(bsz, s_len, ATT_KV_HEADS, HEAD_DIM),
                           av.reshape(bsz, s_len, ATT_KV_HEADS, HEAD_DIM), att_sinks[l], pos)
        y_gla = gla_branch(gq, gk, gv, g_lr, g_out, gla_w_gate[l], gla_b_gate[l], gla_norm_g[l])
        gates = jax.nn.sigmoid(merge).reshape(bsz, s_len, 3, D_MODEL)
        mixed = (gates[:, :, 0] * (y_ssm @ w_branch_ssm[l])
                 + gates[:, :, 1] * (y_att @ w_branch_att[l])
                 + gates[:, :, 2] * (y_gla @ w_branch_gla[l]))
        x = x + mixed @ w_out[l]
        h2 = rms_norm(x, norm2_g[l])
        x = x + jnp.square(jax.nn.relu(h2 @ w_ff1[l])) @ w_ff2[l]
    return rms_norm(x, final_norm_g)
```

```cpp
#include <hip/hip_runtime.h>
#include <hip/hip_cooperative_groups.h>
#include <cstdio>
namespace cg = cooperative_groups;

#ifndef DBG_STOP
#define DBG_STOP -1
#endif
#ifndef MK_LAUNCH_PER_PHASE
#define MK_LAUNCH_PER_PHASE 0
#endif

#ifndef P2MASK
#define P2MASK 7
#endif
#ifndef PHMASK
#define PHMASK 0xfff
#endif
#define PH_ON(k) ((PHMASK >> (k)) & 1)
#define LAS __attribute__((address_space(3)))
typedef unsigned short bf16_t;
typedef short bf16x8 __attribute__((ext_vector_type(8)));
typedef float f32x4 __attribute__((ext_vector_type(4)));
typedef float f32x2 __attribute__((ext_vector_type(2)));
typedef unsigned u32x4 __attribute__((ext_vector_type(4)));
typedef unsigned u32x2 __attribute__((ext_vector_type(2)));

constexpr int SEQ = 16384, DM = 2048, DFF = 8192, NP = 12032;
constexpr int C_U = 0, C_AQ = 1024, C_AK = 2048, C_AV = 2304, C_GQ = 2560, C_GK = 3072, C_GV = 3584, C_GOUT = 4608, C_MERGE = 5632, C_GLR = 11776;
constexpr int IN_W = 11792;
constexpr float EPS = 1e-6f;

constexpr size_t WS_WIN = 0;
constexpr size_t WS_WGLU = WS_WIN + (size_t)NP * DM * 2;
constexpr size_t WS_WBS = WS_WGLU + (size_t)1024 * 1024 * 2;
constexpr size_t WS_WBA = WS_WBS + (size_t)2048 * 1024 * 2;
constexpr size_t WS_WBG = WS_WBA + (size_t)2048 * 1024 * 2;
constexpr size_t WS_WOUT = WS_WBG + (size_t)2048 * 1024 * 2;
constexpr size_t WS_WFF1 = WS_WOUT + (size_t)2048 * 2048 * 2;
constexpr size_t WS_WFF2 = WS_WFF1 + (size_t)DFF * DM * 2;
constexpr size_t WS_P = WS_WFF2 + (size_t)DFF * DM * 2;
constexpr size_t WS_HB = WS_P + (size_t)SEQ * NP * 2;
constexpr size_t WS_GS = WS_HB + (size_t)SEQ * DM * 2;
constexpr size_t WS_GDEC = WS_GS + (size_t)256 * 4 * 256 * 128 * 2;
constexpr size_t WS_S5C = WS_GDEC + (size_t)256 * 4 * 128 * 4;
constexpr size_t WS_SA = WS_S5C + (size_t)256 * 64 * 64 * 8;
constexpr size_t WS_SA64 = WS_SA + (size_t)64 * 64 * 8;
constexpr size_t WS_BB = WS_SA64 + (size_t)64 * 64 * 8;
constexpr size_t WS_CC = WS_BB + (size_t)64 * 128 * 16 * 2;
constexpr size_t WS_ROPE = WS_CC + (size_t)64 * 16 * 128 * 2;
constexpr size_t WS_YA = WS_ROPE + (size_t)SEQ * 64 * 4;
constexpr size_t WS_YG = WS_YA + (size_t)SEQ * 1024 * 2;
constexpr size_t WS_S5S = WS_YG + (size_t)SEQ * 1024 * 2;
constexpr size_t WS_END = WS_S5S + (size_t)256 * 64 * 64 * 8;
constexpr size_t WS_GST = WS_WFF1;

constexpr size_t WS_RSS = WS_END + 16384;
constexpr size_t WS_TOTAL = WS_RSS + (size_t)4 * SEQ * 4;
constexpr int LDS_BYTES = 131072;

struct Params { const float* in[25]; float* out; unsigned char* ws; int ph_lo, ph_hi; };

__device__ __forceinline__ int otid() { int t = __builtin_amdgcn_workitem_id_x(); asm volatile("" : "+v"(t)); return t; }
__device__ __forceinline__ int obid() { int b = __builtin_amdgcn_workgroup_id_x(); asm volatile("" : "+s"(b)); return b; }
typedef const float* cfptr;
__device__ __forceinline__ cfptr kin(int k) { asm volatile("" : "+s"(k)); const __attribute__((address_space(4))) cfptr* ka = (const __attribute__((address_space(4))) cfptr*)__builtin_amdgcn_kernarg_segment_ptr(); return ka[k]; }
typedef __bf16 bf16x2v __attribute__((ext_vector_type(2)));
__device__ __forceinline__ unsigned cvt_pk_bf16(float lo, float hi) { f32x2 v = {lo, hi}; bf16x2v r = __builtin_convertvector(v, bf16x2v); return __builtin_bit_cast(unsigned, r); }
__device__ __forceinline__ bf16_t f2bf(float f) { const __bf16 b = (__bf16)f; return __builtin_bit_cast(unsigned short, b); }
__device__ __forceinline__ float bflo(unsigned w) { return __uint_as_float(w << 16); }
__device__ __forceinline__ float bfhi(unsigned w) { return __uint_as_float(w & 0xffff0000u); }
__device__ __forceinline__ float bf2f(bf16_t b) { return __uint_as_float(((unsigned)b) << 16); }
__device__ __forceinline__ float sigmoidf_(float x) { return __builtin_amdgcn_rcpf(1.0f + __expf(-x)); }
__device__ __forceinline__ float wave_sum(float v) {
#pragma unroll
    for (int o = 1; o < 64; o <<= 1) v += __shfl_xor(v, o);
    return v;
}
__device__ __forceinline__ void unpack8(const u32x4 w, float (&f)[8]) {
    f[0] = bflo(w.x); f[1] = bfhi(w.x); f[2] = bflo(w.y); f[3] = bfhi(w.y); f[4] = bflo(w.z); f[5] = bfhi(w.z); f[6] = bflo(w.w); f[7] = bfhi(w.w);
}
__device__ __forceinline__ u32x4 pack8(const float (&f)[8]) {
    u32x4 w; w.x = cvt_pk_bf16(f[0], f[1]); w.y = cvt_pk_bf16(f[2], f[3]); w.z = cvt_pk_bf16(f[4], f[5]); w.w = cvt_pk_bf16(f[6], f[7]); return w;
}
__device__ __forceinline__ bf16x8 as_bf16x8(u32x4 w) { return __builtin_bit_cast(bf16x8, w); }
#ifndef REPMASK
#define REPMASK 0
#endif
#ifndef MFMA_PAD
#define MFMA_PAD 0
#endif
__device__ __forceinline__ f32x4 mfma16_pad(bf16x8 a, bf16x8 b, f32x4 c) {
    f32x4 d = __builtin_amdgcn_mfma_f32_16x16x32_bf16(a, b, c, 0, 0, 0);
#if MFMA_PAD
    asm volatile("s_nop 7\n\ts_nop 7\n\ts_nop 7" : "+v"(d));
#endif
    return d;
}
#define MFMA16(a, b, c) mfma16_pad((a), (b), (c))
#define LDS_FENCE() asm volatile("s_waitcnt lgkmcnt(0)" ::: "memory")

__device__ __forceinline__ void cplx_step(const f32x2 A, float& sr, float& si, const float xr, const float xi) {
    float a1 = A.x * sr; asm volatile("" : "+v"(a1), "+v"(si));
    float a2 = A.y * si; asm volatile("" : "+v"(a2), "+v"(sr));
    float nr = (a1 - a2) + xr; asm volatile("" : "+v"(nr), "+v"(si));
    float b1 = A.x * si; asm volatile("" : "+v"(b1), "+v"(sr));
    float b2 = A.y * sr; asm volatile("" : "+v"(b2));
    const float ni = (b1 + b2) + xi;
    sr = nr; si = ni;
}
__device__ __forceinline__ void sincos_d(double x, double& s, double& c) {
    const double k = rint(x * 0.63661977236758134308);
    double r = fma(-k, 1.57079632679489655800e+00, x);
    r = fma(-k, 6.12323399573676603587e-17, r);
    const double r2 = r * r;
    double sp = 1.0 / 6227020800.0; sp = fma(sp, r2, -1.0 / 39916800.0); sp = fma(sp, r2, 1.0 / 362880.0); sp = fma(sp, r2, -1.0 / 5040.0); sp = fma(sp, r2, 1.0 / 120.0); sp = fma(sp, r2, -1.0 / 6.0);
    const double sr = fma(sp * r2, r, r);
    double cp = 1.0 / 479001600.0; cp = fma(cp, r2, -1.0 / 3628800.0); cp = fma(cp, r2, 1.0 / 40320.0); cp = fma(cp, r2, -1.0 / 720.0); cp = fma(cp, r2, 1.0 / 24.0); cp = fma(cp, r2, -0.5);
    const double cr = fma(cp, r2, 1.0);
    const int q = ((int)k) & 3;
    s = (q == 0) ? sr : (q == 1) ? cr : (q == 2) ? -sr : -cr;
    c = (q == 0) ? cr : (q == 1) ? -sr : (q == 2) ? -cr : sr;
}
__device__ __forceinline__ double exp_d(double x) {
    const double k = rint(x * 1.44269504088896340736);
    const double r = fma(-k, 6.93147180369123816490e-01, x) - k * 1.90821492927058770002e-10;
    double p = 1.0 / 6227020800.0;
    p = fma(p, r, 1.0 / 479001600.0); p = fma(p, r, 1.0 / 39916800.0); p = fma(p, r, 1.0 / 3628800.0); p = fma(p, r, 1.0 / 362880.0); p = fma(p, r, 1.0 / 40320.0);
    p = fma(p, r, 1.0 / 5040.0); p = fma(p, r, 1.0 / 720.0); p = fma(p, r, 1.0 / 120.0); p = fma(p, r, 1.0 / 24.0); p = fma(p, r, 1.0 / 6.0); p = fma(p, r, 0.5); p = fma(p, r, 1.0); p = fma(p, r, 1.0);
    return ldexp(p, (int)k);
}

namespace pg8 {
constexpr int BM = 256, BK = 64, HALF = 128, HTB = HALF * BK * 2, STAGE_BYTES = 8 * HTB, NXCD = 8, WGM = 8;
__device__ __forceinline__ int lds_byte(int r, int c) { const int st = (r >> 4) * 2 + (c >> 5), rr = r & 15, cc = c & 31, ob = rr * 64 + cc * 2; return st * 1024 + (ob ^ (((ob >> 9) & 1) << 5)); }
__device__ __forceinline__ void stage_rc(int b, int& R, int& C) { const int st = b / 1024, sb = b % 1024, swz = sb ^ (((sb >> 9) & 1) << 5); R = (st >> 1) * 16 + swz / 64; C = (st & 1) * 32 + (swz % 64) / 2; }
__device__ __forceinline__ int perm32(int rho) { const int n = rho >> 4, i = rho & 15; return 8 * (i >> 2) + 4 * n + (i & 3); }
struct Unit { int pm, pn; };
struct Gemm { const bf16_t* A; const bf16_t* Bt; int M, N, K, lda; };
struct StaticOrder {
    int nM, nN, nwg, G, c;
    __device__ void init(int M, int N, int G_, int c_) { nM = M / BM; nN = N / BM; nwg = nM * nN; G = G_; c = c_; }
    __device__ bool next(int i, Unit& u) const {
        const long L = (long)i * G + c; if (L >= nwg) return false;
        int wgid = (int)L; { const int q = nwg / NXCD, r = nwg % NXCD, xcd = wgid % NXCD, off = wgid / NXCD; wgid = (xcd < r ? xcd * (q + 1) : r * (q + 1) + (xcd - r) * q) + off; }
        const int nig = WGM * nN, gid = wgid / nig, fm = gid * WGM, gsz = (nM - fm) < WGM ? (nM - fm) : WGM;
        u.pm = fm + ((wgid % nig) % gsz); u.pn = (wgid % nig) / gsz; return true;
    }
};

template <class Epi>
__device__ __forceinline__ void gemm_phase(LAS unsigned char* lds, const Gemm g, const Epi& E) {
    const int tid = otid(), wid = __builtin_amdgcn_readfirstlane(tid >> 6), lane = tid & 63, wr = wid >> 2, wc = wid & 3, fr = lane & 15, fq = lane >> 4;
    const int K = g.K, nt = K / BK, lda = g.lda;
    unsigned voffA[2], voffB[2];
#pragma unroll
    for (int i = 0; i < 2; ++i) { int R, C; stage_rc(tid * 16 + i * 8192, R, C); const int Rb = Epi::PERM ? ((R & ~31) + perm32(R & 31)) : R;
        voffA[i] = (unsigned)(R * lda + C) * 2u; voffB[i] = (unsigned)(Rb * K + C) * 2u; }
    const size_t kstep = (size_t)(BK * 2);
    const size_t hstepA = (size_t)HALF * lda * 2, hstepB = (size_t)HALF * K * 2;
    const size_t tstepA = 2 * hstepA, tstepB = 2 * hstepB;
    const unsigned ldsw = (unsigned)wid * 1024u;
    const int aoff = lds_byte(wr * 64 + fr, fq * 8), boff = lds_byte(wc * 32 + fr, fq * 8);
#define PG8_SA(b, h) (((b) * 2 + (h)) * HTB)
#define PG8_SB(b, h) ((4 + (b) * 2 + (h)) * HTB)
#define PG8_STAGE(bufoff, gbase, voff) do { _Pragma("unroll") for (int _i = 0; _i < 2; ++_i) \
        __builtin_amdgcn_global_load_lds((const unsigned*)((const char*)(gbase) + (voff)[_i]), (LAS unsigned*)(lds + (bufoff) + ldsw + _i * 8192), 16, 0, 0); } while (0)
#define PG8_LDA(dst, b, h) do { _Pragma("unroll") for (int m = 0; m < 4; ++m) _Pragma("unroll") for (int k = 0; k < 2; ++k) dst[m][k] = *(const LAS bf16x8*)(lds + PG8_SA(b, h) + aoff + m * 2048 + k * 1024); } while (0)
#define PG8_LDB(dst, b, h) do { _Pragma("unroll") for (int n = 0; n < 2; ++n) _Pragma("unroll") for (int k = 0; k < 2; ++k) dst[n][k] = *(const LAS bf16x8*)(lds + PG8_SB(b, h) + boff + n * 2048 + k * 1024); } while (0)
#define PG8_MMA(ai, bj, At, Bt) do { __builtin_amdgcn_s_setprio(1); _Pragma("unroll") for (int m = 0; m < 4; ++m) _Pragma("unroll") for (int n = 0; n < 2; ++n) _Pragma("unroll") for (int k = 0; k < 2; ++k) \
        acc[ai][bj][m][n] = __builtin_amdgcn_mfma_f32_16x16x32_bf16(Bt[n][k], At[m][k], acc[ai][bj][m][n], 0, 0, 0); __builtin_amdgcn_s_setprio(0); } while (0)
#define PG8_WAIT_V(n) asm volatile("s_waitcnt vmcnt(" #n ")" ::: "memory")
#define PG8_WAIT_L(n) asm volatile("s_waitcnt lgkmcnt(" #n ")" ::: "memory")
#define PG8_BAR __builtin_amdgcn_s_barrier()
#define PG8_SCHED __builtin_amdgcn_sched_barrier(0)
    StaticOrder S; S.init(g.M, g.N, (int)gridDim.x, (int)obid());
    Unit cur, nxt; int ui = 0;
    if (!S.next(0, cur)) return;
    f32x4 acc[2][2][4][2];
#pragma unroll
    for (int a = 0; a < 2; ++a)
#pragma unroll
        for (int b = 0; b < 2; ++b)
#pragma unroll
            for (int m = 0; m < 4; ++m)
#pragma unroll
                for (int n = 0; n < 2; ++n) acc[a][b][m][n] = (f32x4){0.f, 0.f, 0.f, 0.f};
    bf16x8 At[4][2], B0[2][2], B1[2][2];
    const char* cA = (const char*)g.A + (size_t)cur.pm * tstepA; const char* cB = (const char*)g.Bt + (size_t)cur.pn * tstepB;
    PG8_STAGE(PG8_SB(0, 0), cB, voffB); PG8_STAGE(PG8_SA(0, 0), cA, voffA); PG8_STAGE(PG8_SB(0, 1), cB + hstepB, voffB); PG8_STAGE(PG8_SA(0, 1), cA + hstepA, voffA);
    if (wr == 1) PG8_BAR;
    PG8_WAIT_V(4); PG8_BAR;
    PG8_STAGE(PG8_SB(1, 0), cB + kstep, voffB); PG8_STAGE(PG8_SA(1, 0), cA + kstep, voffA); PG8_STAGE(PG8_SB(1, 1), cB + hstepB + kstep, voffB);
    PG8_WAIT_V(6); PG8_BAR;
    for (;;) {
        const bool has_next = S.next(ui + 1, nxt);
        const char* nA = has_next ? (const char*)g.A + (size_t)nxt.pm * tstepA : cA; const char* nB = has_next ? (const char*)g.Bt + (size_t)nxt.pn * tstepB : cB;
        for (int t = 0; t < nt; t += 2) {
            const bool last = (t == nt - 2);
            const char* a1 = cA + (size_t)(t + 1) * kstep;
            const char* a2 = last ? nA : cA + (size_t)(t + 2) * kstep; const char* b2 = last ? nB : cB + (size_t)(t + 2) * kstep;
            const char* a3 = a2 + kstep; const char* b3 = b2 + kstep;
            PG8_LDB(B0, 0, 0); PG8_SCHED; PG8_LDA(At, 0, 0); PG8_STAGE(PG8_SA(1, 1), a1 + hstepA, voffA);
            PG8_WAIT_L(8); PG8_BAR; PG8_WAIT_L(0); PG8_MMA(0, 0, At, B0); PG8_BAR; PG8_SCHED;
            PG8_LDB(B1, 0, 1); PG8_STAGE(PG8_SB(0, 0), b2, voffB);
            PG8_BAR; PG8_WAIT_L(0); PG8_MMA(0, 1, At, B1); PG8_BAR;
            PG8_LDA(At, 0, 1); PG8_STAGE(PG8_SA(0, 0), a2, voffA);
            PG8_BAR; PG8_WAIT_L(0); PG8_MMA(1, 0, At, B0); PG8_BAR; PG8_SCHED;
            PG8_STAGE(PG8_SB(0, 1), b2 + hstepB, voffB);
            PG8_WAIT_V(6); PG8_BAR; PG8_MMA(1, 1, At, B1); PG8_BAR;
            PG8_LDB(B0, 1, 0); PG8_SCHED; PG8_LDA(At, 1, 0); PG8_STAGE(PG8_SA(0, 1), a2 + hstepA, voffA);
            PG8_WAIT_L(8); PG8_BAR; PG8_WAIT_L(0); PG8_MMA(0, 0, At, B0); PG8_BAR; PG8_SCHED;
            PG8_LDB(B1, 1, 1); PG8_STAGE(PG8_SB(1, 0), b3, voffB);
            PG8_BAR; PG8_WAIT_L(0); PG8_MMA(0, 1, At, B1); PG8_BAR;
            PG8_LDA(At, 1, 1); PG8_STAGE(PG8_SA(1, 0), a3, voffA);
            PG8_BAR; PG8_WAIT_L(0); PG8_MMA(1, 0, At, B0); PG8_BAR; PG8_SCHED;
            PG8_STAGE(PG8_SB(1, 1), b3 + hstepB, voffB);
            PG8_WAIT_V(6); PG8_BAR; PG8_MMA(1, 1, At, B1); PG8_BAR;
        }
        E(acc, cur, wr, wc, fr, fq);
        if (!has_next) break;
#pragma unroll
        for (int a = 0; a < 2; ++a)
#pragma unroll
            for (int b = 0; b < 2; ++b)
#pragma unroll
                for (int m = 0; m < 4; ++m)
#pragma unroll
                    for (int n = 0; n < 2; ++n) acc[a][b][m][n] = (f32x4){0.f, 0.f, 0.f, 0.f};
        cur = nxt; cA = nA; cB = nB; ++ui;
    }
    PG8_WAIT_V(0);
    if (wr == 0) PG8_BAR;
    PG8_BAR;
#undef PG8_SA
#undef PG8_SB
#undef PG8_STAGE
#undef PG8_LDA
#undef PG8_LDB
#undef PG8_MMA
#undef PG8_WAIT_V
#undef PG8_WAIT_L
#undef PG8_BAR
#undef PG8_SCHED
}

struct EpiProj {
    static constexpr bool PERM = true;
    bf16_t* P; const float* rss;
    __device__ __forceinline__ void operator()(const f32x4 (&acc)[2][2][4][2], const Unit& u, int wr, int wc, int fr, int fq) const {
        const int row0 = u.pm * BM + wr * 64 + fr, col0 = u.pn * BM + wc * 32 + 8 * fq;
        const bool sg = (u.pn >= 22) && (u.pn < 46);
        float rsv[2][4];
#pragma unroll
        for (int ai = 0; ai < 2; ++ai)
#pragma unroll
            for (int m = 0; m < 4; ++m) rsv[ai][m] = rss[row0 + ai * HALF + m * 16];
#pragma unroll
        for (int ai = 0; ai < 2; ++ai)
#pragma unroll
            for (int m = 0; m < 4; ++m) { bf16_t* rowp = P + (size_t)(row0 + ai * HALF + m * 16) * NP + col0;
                const float rs = __builtin_amdgcn_rsqf(rsv[ai][m] * (1.0f / DM) + EPS);
#pragma unroll
                for (int bj = 0; bj < 2; ++bj) { f32x4 v0 = acc[ai][bj][m][0] * rs, v1 = acc[ai][bj][m][1] * rs;
                    if (sg) {
#pragma unroll
                        for (int j = 0; j < 4; ++j) { v0[j] = sigmoidf_(v0[j]); v1[j] = sigmoidf_(v1[j]); } }
                    u32x4 w; w.x = cvt_pk_bf16(v0[0], v0[1]); w.y = cvt_pk_bf16(v0[2], v0[3]); w.z = cvt_pk_bf16(v1[0], v1[1]); w.w = cvt_pk_bf16(v1[2], v1[3]);
                    *(u32x4*)(rowp + bj * HALF) = w; } }
    }
};
struct EpiGlu {
    static constexpr bool PERM = true;
    bf16_t* P; const float* bias;
    __device__ __forceinline__ void operator()(const f32x4 (&acc)[2][2][4][2], const Unit& u, int wr, int wc, int fr, int fq) const {
        const int row0 = u.pm * BM + wr * 64 + fr, col0 = u.pn * BM + wc * 32 + 8 * fq;
        f32x4 bv[2][2];
#pragma unroll
        for (int bj = 0; bj < 2; ++bj)
#pragma unroll
            for (int n = 0; n < 2; ++n) bv[bj][n] = *(const f32x4*)(bias + col0 + bj * HALF + 4 * n);
#pragma unroll
        for (int ai = 0; ai < 2; ++ai) {
            u32x4 zw[4][2];
#pragma unroll
            for (int m = 0; m < 4; ++m)
#pragma unroll
                for (int bj = 0; bj < 2; ++bj) zw[m][bj] = *(const u32x4*)(P + (size_t)(row0 + ai * HALF + m * 16) * NP + col0 + C_AQ + bj * HALF);
#pragma unroll
            for (int m = 0; m < 4; ++m) { bf16_t* rowp = P + (size_t)(row0 + ai * HALF + m * 16) * NP + col0;
#pragma unroll
                for (int bj = 0; bj < 2; ++bj) { const f32x4 v0 = acc[ai][bj][m][0] + bv[bj][0], v1 = acc[ai][bj][m][1] + bv[bj][1];
                    float z[8]; unpack8(zw[m][bj], z);
                    float o[8];
#pragma unroll
                    for (int j = 0; j < 4; ++j) { o[j] = z[j] * sigmoidf_(v0[j]); o[4 + j] = z[4 + j] * sigmoidf_(v1[j]); }
                    *(u32x4*)(rowp + C_GQ + bj * HALF) = pack8(o); } }
            asm volatile("" ::: "memory"); }
    }
};
struct EpiBranch {
    static constexpr bool PERM = true;
    const bf16_t* P; bf16_t* MX; int br;
    __device__ __forceinline__ void operator()(const f32x4 (&acc)[2][2][4][2], const Unit& u, int wr, int wc, int fr, int fq) const {
        const int row0 = u.pm * BM + wr * 64 + fr, col0 = u.pn * BM + wc * 32 + 8 * fq;
#pragma unroll
        for (int ai = 0; ai < 2; ++ai) {
            u32x4 gw[4][2], pw[4][2];
#pragma unroll
            for (int m = 0; m < 4; ++m)
#pragma unroll
                for (int bj = 0; bj < 2; ++bj) { const size_t r = (size_t)(row0 + ai * HALF + m * 16);
                    gw[m][bj] = *(const u32x4*)(P + r * NP + C_MERGE + br * 2048 + col0 + bj * HALF);
                    pw[m][bj] = (u32x4){0u, 0u, 0u, 0u};
                    if (br > 0) pw[m][bj] = *(const u32x4*)(MX + r * DM + col0 + bj * HALF); }
#pragma unroll
            for (int m = 0; m < 4; ++m) { const size_t r = (size_t)(row0 + ai * HALF + m * 16);
#pragma unroll
                for (int bj = 0; bj < 2; ++bj) { const f32x4 v0 = acc[ai][bj][m][0], v1 = acc[ai][bj][m][1];
                    float gt[8], pv[8]; unpack8(gw[m][bj], gt); unpack8(pw[m][bj], pv);
                    float o[8];
#pragma unroll
                    for (int j = 0; j < 4; ++j) { o[j] = pv[j] + gt[j] * v0[j]; o[4 + j] = pv[4 + j] + gt[4 + j] * v1[j]; }
                    *(u32x4*)(MX + r * DM + col0 + bj * HALF) = pack8(o); } }
            asm volatile("" ::: "memory"); }
    }
};
struct EpiResid {
    static constexpr bool PERM = false;
    const float* base; float* out; bf16_t* xb; float* rss;
    __device__ __forceinline__ void operator()(const f32x4 (&acc)[2][2][4][2], const Unit& u, int wr, int wc, int fr, int fq) const {
        const int row0 = u.pm * BM + wr * 64 + fr, col0 = u.pn * BM + wc * 32 + 4 * fq;
#pragma unroll
        for (int ai = 0; ai < 2; ++ai) {
            f32x4 bsv[4][2][2];
#pragma unroll
            for (int m = 0; m < 4; ++m)
#pragma unroll
                for (int bj = 0; bj < 2; ++bj)
#pragma unroll
                    for (int n = 0; n < 2; ++n) bsv[m][bj][n] = *(const f32x4*)(base + (size_t)(row0 + ai * HALF + m * 16) * DM + col0 + bj * HALF + n * 16);
#pragma unroll
            for (int m = 0; m < 4; ++m) { const size_t off = (size_t)(row0 + ai * HALF + m * 16) * DM + col0;
                float ss = 0.f;
#pragma unroll
                for (int bj = 0; bj < 2; ++bj)
#pragma unroll
                    for (int n = 0; n < 2; ++n) { const f32x4 o = bsv[m][bj][n] + acc[ai][bj][m][n];
                        *(f32x4*)(out + off + bj * HALF + n * 16) = o;
                        if (xb) { u32x2 w; w.x = cvt_pk_bf16(o[0], o[1]); w.y = cvt_pk_bf16(o[2], o[3]); *(u32x2*)(xb + off + bj * HALF + n * 16) = w;
                            ss += (o[0] * o[0] + o[1] * o[1]) + (o[2] * o[2] + o[3] * o[3]); } }
                if (xb) { ss += __shfl_xor(ss, 16); ss += __shfl_xor(ss, 32);
                    if (fq == 0) atomicAdd(rss + row0 + ai * HALF + m * 16, ss); } }
            asm volatile("" ::: "memory"); }
    }
};
struct EpiRelu2 {
    static constexpr bool PERM = true;
    bf16_t* H; const float* rss;
    __device__ __forceinline__ void operator()(const f32x4 (&acc)[2][2][4][2], const Unit& u, int wr, int wc, int fr, int fq) const {
        const int row0 = u.pm * BM + wr * 64 + fr, col0 = u.pn * BM + wc * 32 + 8 * fq;
        float rsv[2][4];
#pragma unroll
        for (int ai = 0; ai < 2; ++ai)
#pragma unroll
            for (int m = 0; m < 4; ++m) rsv[ai][m] = rss[row0 + ai * HALF + m * 16];
#pragma unroll
        for (int ai = 0; ai < 2; ++ai)
#pragma unroll
            for (int m = 0; m < 4; ++m) { bf16_t* rowp = H + (size_t)(row0 + ai * HALF + m * 16) * DFF + col0;
                const float rs = __builtin_amdgcn_rsqf(rsv[ai][m] * (1.0f / DM) + EPS);
#pragma unroll
                for (int bj = 0; bj < 2; ++bj) { f32x4 v0 = acc[ai][bj][m][0] * rs, v1 = acc[ai][bj][m][1] * rs;
#pragma unroll
                    for (int j = 0; j < 4; ++j) { const float a = fmaxf(v0[j], 0.f), b = fmaxf(v1[j], 0.f); v0[j] = a * a; v1[j] = b * b; }
                    u32x4 w; w.x = cvt_pk_bf16(v0[0], v0[1]); w.y = cvt_pk_bf16(v0[2], v0[3]); w.z = cvt_pk_bf16(v1[0], v1[1]); w.w = cvt_pk_bf16(v1[2], v1[3]);
                    *(u32x4*)(rowp + bj * HALF) = w; } }
    }
};
}

__device__ __forceinline__ void conv_tile(const float* src, int ldsrc, int K, bf16_t* dst, int k0, int n0, bool win, const float* gk, LAS bf16_t* T, int lane) {
    const int nl = (lane & 15) * 4, np = n0 + nl;
    int sc = np; bool valid = true;
    if (win) { if (np < 4608) sc = np; else if (np < 11776) sc = np + 16; else if (np < 11792) sc = np - 11776 + 4608; else valid = false; }
    f32x4 cv[16];
#pragma unroll
    for (int i = 0; i < 16; ++i) { cv[i] = (f32x4){0.f, 0.f, 0.f, 0.f}; if (valid) cv[i] = *(const f32x4*)(src + (size_t)(k0 + i * 4 + (lane >> 4)) * ldsrc + sc); }
    if (gk) {
#pragma unroll
        for (int i = 0; i < 16; ++i) cv[i] = cv[i] * gk[k0 + i * 4 + (lane >> 4)]; }
#pragma unroll
    for (int i = 0; i < 16; ++i) {
        const int kk = i * 4 + (lane >> 4);
        const f32x4 v = cv[i];
        T[(nl + 0) * 72 + kk] = f2bf(v[0]); T[(nl + 1) * 72 + kk] = f2bf(v[1]); T[(nl + 2) * 72 + kk] = f2bf(v[2]); T[(nl + 3) * 72 + kk] = f2bf(v[3]);
    }
    LDS_FENCE();
#pragma unroll
    for (int i = 0; i < 8; ++i) {
        const int n = i * 8 + (lane >> 3), c = lane & 7;
        const u32x4 w = *(const LAS u32x4*)(T + n * 72 + c * 8);
        *(u32x4*)(dst + (size_t)(n0 + n) * K + k0 + c * 8) = w;
    }
    LDS_FENCE();
}

template <bool FFN>
__device__ __forceinline__ void phase_conv(const Params& p, int l, LAS unsigned char* lds) {
    const int tid = otid(), lane = tid & 63, wid = tid >> 6;
    unsigned char* ws = p.ws;
    if (!FFN && obid() < 8) {
        const int gp = obid() * 512 + tid, g = gp >> 6, pp = gp & 63;
        const double lr = (double)kin(3)[(size_t)l * 4096 + gp], li = (double)kin(4)[(size_t)l * 4096 + gp];
        const double step = exp_d((double)kin(5)[l * 64 + g]);
        const double mag = exp_d(lr * step);
        double sn, cs; sincos_d(li * step, sn, cs);
        const double ar = mag * cs, ai = mag * sn, den = lr * lr + li * li;
        const double fr = ((ar - 1.0) * lr + ai * li) / den, fi = (ai * lr - (ar - 1.0) * li) / den;
        ((f32x2*)(ws + WS_SA))[gp] = (f32x2){(float)ar, (float)ai};
        double pr = ar, pi = ai;
#pragma unroll
        for (int i = 0; i < 6; ++i) { const double nr = pr * pr - pi * pi, ni = 2.0 * pr * pi; pr = nr; pi = ni; }
        ((f32x2*)(ws + WS_SA64))[gp] = (f32x2){(float)pr, (float)pi};
        const float* bre = kin(6) + ((size_t)l * 4096 + gp) * 16; const float* bim = kin(7) + ((size_t)l * 4096 + gp) * 16;
        bf16_t* bb = (bf16_t*)(ws + WS_BB) + (size_t)g * 128 * 16;
#pragma unroll
        for (int c = 0; c < 16; ++c) { const double br = bre[c], bi = bim[c];
            bb[pp * 16 + c] = f2bf((float)(fr * br - fi * bi)); bb[(64 + pp) * 16 + c] = f2bf((float)(fr * bi + fi * br)); }
        const float* cre = kin(8) + ((size_t)l * 64 + g) * 16 * 64; const float* cim = kin(9) + ((size_t)l * 64 + g) * 16 * 64;
        bf16_t* cc = (bf16_t*)(ws + WS_CC) + (size_t)g * 16 * 128;
#pragma unroll
        for (int c = 0; c < 16; ++c) { cc[c * 128 + pp] = f2bf(cre[c * 64 + pp]); cc[c * 128 + 64 + pp] = f2bf(-cim[c * 64 + pp]); }
    }
    if (!FFN && l == 0) {
        float* rt = (float*)(ws + WS_ROPE);
        for (int idx = obid() * 512 + tid; idx < SEQ * 32; idx += gridDim.x * 512) {
            const int pos = idx >> 5, i = idx & 31;
            const float inv = (float)exp_d(-(double)i * (9.21034037197618273607 / 32.0));
            const float ang = (float)pos * inv;
            double sn, cs; sincos_d((double)ang, sn, cs);
            rt[pos * 64 + i] = (float)cs; rt[pos * 64 + 32 + i] = (float)sn;
        }
    }
    LAS bf16_t* T = (LAS bf16_t*)(lds + wid * 9216);
    const int gw = wid * gridDim.x + obid(), nw = gridDim.x * 8;
    const int ntile[8] = {32 * 188, 16 * 16, 16 * 32, 16 * 32, 16 * 32, 32 * 32, 32 * 128, 128 * 32};
    int total = 0;
#pragma unroll
    for (int i = 0; i < 8; ++i) total += ntile[i];
    const int first6 = ntile[0] + ntile[1] + ntile[2] + ntile[3] + ntile[4] + ntile[5];
    for (int it = (FFN ? first6 : 0) + gw; it < (FFN ? total : first6); it += nw) {
        int r = it, mi = 0;
#pragma unroll
        for (int i = 0; i < 7; ++i) { if (mi == i && r >= ntile[i]) { r -= ntile[i]; mi = i + 1; } }
        const float* src; bf16_t* dst; int K, N, ldsrc; bool win = false; const float* gk = nullptr;
        switch (mi) {
            case 0: src = kin(2) + (size_t)l * DM * IN_W; dst = (bf16_t*)(ws + WS_WIN); K = DM; N = NP; ldsrc = IN_W; win = true; gk = kin(1) + (size_t)l * DM; break;
            case 1: src = kin(11) + (size_t)l * 1024 * 1024; dst = (bf16_t*)(ws + WS_WGLU); K = 1024; N = 1024; ldsrc = 1024; break;
            case 2: src = kin(17) + (size_t)l * 1024 * DM; dst = (bf16_t*)(ws + WS_WBS); K = 1024; N = DM; ldsrc = DM; break;
            case 3: src = kin(18) + (size_t)l * 1024 * DM; dst = (bf16_t*)(ws + WS_WBA); K = 1024; N = DM; ldsrc = DM; break;
            case 4: src = kin(19) + (size_t)l * 1024 * DM; dst = (bf16_t*)(ws + WS_WBG); K = 1024; N = DM; ldsrc = DM; break;
            case 5: src = kin(20) + (size_t)l * DM * DM; dst = (bf16_t*)(ws + WS_WOUT); K = DM; N = DM; ldsrc = DM; break;
            case 6: src = kin(22) + (size_t)l * DM * DFF; dst = (bf16_t*)(ws + WS_WFF1); K = DM; N = DFF; ldsrc = DFF; gk = kin(21) + (size_t)l * DM; break;
            default: src = kin(23) + (size_t)l * DFF * DM; dst = (bf16_t*)(ws + WS_WFF2); K = DFF; N = DM; ldsrc = DM; break;
        }
        const int nnt = N / 64, kt = r / nnt, ntl = r % nnt;
        conv_tile(src, ldsrc, K, dst, kt * 64, ntl * 64, win, gk, T, lane);
    }
}

template <bool TO_BF16>
__device__ __forceinline__ void phase_norm(const float* x, const float* g, bf16_t* hb, float* outf) {
    const int lane = otid() & 63, wid = otid() >> 6;
    const int gw = obid() * 8 + wid, nw = gridDim.x * 8;
    for (int row = gw; row < SEQ; row += nw) {
        const f32x4* xr = (const f32x4*)(x + (size_t)row * DM) + lane;
        f32x4 v[8]; float s = 0.f;
#pragma unroll
        for (int j = 0; j < 8; ++j) { v[j] = xr[64 * j]; s += (v[j][0] * v[j][0] + v[j][1] * v[j][1]) + (v[j][2] * v[j][2] + v[j][3] * v[j][3]); }
        s = wave_sum(s);
        const float rs = 1.0f / sqrtf(s * (1.0f / DM) + EPS);
#pragma unroll
        for (int j = 0; j < 8; ++j) {
            const f32x4 gv = *((const f32x4*)g + lane + 64 * j);
            const f32x4 o = v[j] * rs * gv;
            if (TO_BF16) { u32x2 w; w.x = cvt_pk_bf16(o[0], o[1]); w.y = cvt_pk_bf16(o[2], o[3]); *((u32x2*)(hb + (size_t)row * DM) + lane + 64 * j) = w; }
            else *((f32x4*)(outf + (size_t)row * DM) + lane + 64 * j) = o;
        }
    }
}

__device__ __forceinline__ void phase_xb(const float* x, bf16_t* xb, float* rss) {
    const int lane = otid() & 63, wid = otid() >> 6;
    const int gw = obid() * 8 + wid, nw = gridDim.x * 8;
    for (int row = gw; row < SEQ; row += nw) {
        const f32x4* xr = (const f32x4*)(x + (size_t)row * DM) + lane;
        f32x4 v[8]; float s = 0.f;
#pragma unroll
        for (int j = 0; j < 8; ++j) { v[j] = xr[64 * j]; s += (v[j][0] * v[j][0] + v[j][1] * v[j][1]) + (v[j][2] * v[j][2] + v[j][3] * v[j][3]); }
        s = wave_sum(s);
        if (lane == 0) rss[row] = s;
#pragma unroll
        for (int j = 0; j < 8; ++j) { u32x2 w; w.x = cvt_pk_bf16(v[j][0], v[j][1]); w.y = cvt_pk_bf16(v[j][2], v[j][3]); *((u32x2*)(xb + (size_t)row * DM) + lane + 64 * j) = w; }
    }
}

__device__ __forceinline__ void swa_item(const bf16_t* P, bf16_t* YA, const float* rope, const float* sinks, int n, int kvh, LAS unsigned char* lds) {
    const int tid = otid(), lane = tid & 63, wid = tid >> 6, l15 = lane & 15, g4 = lane >> 4;
    LAS bf16_t* Ks = (LAS bf16_t*)lds;
    LAS bf16_t* Vt = (LAS bf16_t*)(lds + 36864);
    {
        const int j = tid >> 1, hf = tid & 1, row = n * 128 - 128 + j;
        float o1[16], o2[16];
        if (row >= 0) {
            const bf16_t* kp = P + (size_t)row * NP + C_AK + kvh * 64 + hf * 16;
            const u32x4 a0 = *(const u32x4*)kp, a1 = *(const u32x4*)(kp + 8), b0 = *(const u32x4*)(kp + 32), b1 = *(const u32x4*)(kp + 40);
            float x1[16], x2[16];
            { float t[8]; unpack8(a0, t);
#pragma unroll
              for (int i = 0; i < 8; ++i) x1[i] = t[i]; unpack8(a1, t);
#pragma unroll
              for (int i = 0; i < 8; ++i) x1[8 + i] = t[i]; unpack8(b0, t);
#pragma unroll
              for (int i = 0; i < 8; ++i) x2[i] = t[i]; unpack8(b1, t);
#pragma unroll
              for (int i = 0; i < 8; ++i) x2[8 + i] = t[i]; }
            const float* rp = rope + (size_t)row * 64 + hf * 16;
#pragma unroll
            for (int i = 0; i < 16; i += 4) { const f32x4 c = *(const f32x4*)(rp + i), s = *(const f32x4*)(rp + 32 + i);
#pragma unroll
                for (int e = 0; e < 4; ++e) { o1[i + e] = x1[i + e] * c[e] - x2[i + e] * s[e]; o2[i + e] = x2[i + e] * c[e] + x1[i + e] * s[e]; } }
        } else {
#pragma unroll
            for (int i = 0; i < 16; ++i) { o1[i] = 0.f; o2[i] = 0.f; }
        }
        { float t[8];
#pragma unroll
          for (int i = 0; i < 8; ++i) t[i] = o1[i]; *(LAS u32x4*)(Ks + j * 72 + hf * 16) = pack8(t);
#pragma unroll
          for (int i = 0; i < 8; ++i) t[i] = o1[8 + i]; *(LAS u32x4*)(Ks + j * 72 + hf * 16 + 8) = pack8(t);
#pragma unroll
          for (int i = 0; i < 8; ++i) t[i] = o2[i]; *(LAS u32x4*)(Ks + j * 72 + 32 + hf * 16) = pack8(t);
#pragma unroll
          for (int i = 0; i < 8; ++i) t[i] = o2[8 + i]; *(LAS u32x4*)(Ks + j * 72 + 32 + hf * 16 + 8) = pack8(t); }
        const bf16_t* vp = P + (size_t)(row < 0 ? 0 : row) * NP + C_AV + kvh * 64 + hf * 32;
#pragma unroll
        for (int q = 0; q < 4; ++q) { u32x4 w = *(const u32x4*)(vp + q * 8); if (row < 0) w = (u32x4){0u, 0u, 0u, 0u};
            const int d0 = hf * 32 + q * 8;
            Vt[(d0 + 0) * 264 + j] = (bf16_t)(w.x & 0xffffu); Vt[(d0 + 1) * 264 + j] = (bf16_t)(w.x >> 16);
            Vt[(d0 + 2) * 264 + j] = (bf16_t)(w.y & 0xffffu); Vt[(d0 + 3) * 264 + j] = (bf16_t)(w.y >> 16);
            Vt[(d0 + 4) * 264 + j] = (bf16_t)(w.z & 0xffffu); Vt[(d0 + 5) * 264 + j] = (bf16_t)(w.z >> 16);
            Vt[(d0 + 6) * 264 + j] = (bf16_t)(w.w & 0xffffu); Vt[(d0 + 7) * 264 + j] = (bf16_t)(w.w >> 16); }
    }
    const int hq = kvh * 4 + (wid >> 1);
    const float sink = sinks[hq];
    u32x4 nw1, nw2; f32x4 nc0, nc1, ns0, ns1;
#define SWA_QLOAD(QT) do { const int qrow_ = n * 128 + (wid & 1) * 64 + (QT) * 16 + l15; const bf16_t* qp_ = P + (size_t)qrow_ * NP + C_AQ + hq * 64 + g4 * 8; \
        nw1 = *(const u32x4*)qp_; nw2 = *(const u32x4*)(qp_ + 32); const float* rp_ = rope + (size_t)qrow_ * 64 + g4 * 8; \
        nc0 = *(const f32x4*)rp_; nc1 = *(const f32x4*)(rp_ + 4); ns0 = *(const f32x4*)(rp_ + 32); ns1 = *(const f32x4*)(rp_ + 36); } while (0)
    SWA_QLOAD(0);
    __syncthreads();
    for (int qt = 0; qt < 4; ++qt) {
        const int i0 = (wid & 1) * 64 + qt * 16;
        bf16x8 qa0, qa1;
        {   const u32x4 w1 = nw1, w2 = nw2; const f32x4 c0 = nc0, c1 = nc1, s0 = ns0, s1 = ns1;
            if (qt + 1 < 4) SWA_QLOAD(qt + 1);
            float x1[8], x2[8], r1[8], r2[8]; unpack8(w1, x1); unpack8(w2, x2);
#pragma unroll
            for (int e = 0; e < 4; ++e) {
                r1[e] = (x1[e] * c0[e] - x2[e] * s0[e]) * 0.125f; r2[e] = (x2[e] * c0[e] + x1[e] * s0[e]) * 0.125f;
                r1[4 + e] = (x1[4 + e] * c1[e] - x2[4 + e] * s1[e]) * 0.125f; r2[4 + e] = (x2[4 + e] * c1[e] + x1[4 + e] * s1[e]) * 0.125f; }
            qa0 = as_bf16x8(pack8(r1)); qa1 = as_bf16x8(pack8(r2)); }
        const int kt0 = i0 >> 4;
        f32x4 sc[9];
#pragma unroll
        for (int t = 0; t < 9; ++t) {
            const LAS bf16_t* kp = Ks + ((kt0 + t) * 16 + l15) * 72 + g4 * 8;
            const bf16x8 k0 = *(const LAS bf16x8*)kp, k1 = *(const LAS bf16x8*)(kp + 32);
            f32x4 a = (f32x4){0.f, 0.f, 0.f, 0.f};
            a = MFMA16(k0, qa0, a); a = MFMA16(k1, qa1, a);
            sc[t] = a;
        }
        const int qi = i0 + l15;
        float mx = sink;
#pragma unroll
        for (int t = 0; t < 9; ++t)
#pragma unroll
            for (int jj = 0; jj < 4; ++jj) { const int j = (kt0 + t) * 16 + g4 * 4 + jj;
                const bool ok = (j > qi) && (j <= qi + 128) && (n * 128 - 128 + j >= 0);
                sc[t][jj] = ok ? sc[t][jj] : -INFINITY; mx = fmaxf(mx, sc[t][jj]); }
        mx = fmaxf(mx, __shfl_xor(mx, 16)); mx = fmaxf(mx, __shfl_xor(mx, 32));
        float sum = 0.f;
#pragma unroll
        for (int t = 0; t < 9; ++t)
#pragma unroll
            for (int jj = 0; jj < 4; ++jj) { const float e = __expf(sc[t][jj] - mx); sc[t][jj] = e; sum += e; }
        sum += __shfl_xor(sum, 16); sum += __shfl_xor(sum, 32);
        sum += __expf(sink - mx);
        const float inv = 1.0f / sum;
        f32x4 o[4];
#pragma unroll
        for (int dt = 0; dt < 4; ++dt) o[dt] = (f32x4){0.f, 0.f, 0.f, 0.f};
#pragma unroll
        for (int pr = 0; pr < 5; ++pr) {
            const int ta = 2 * pr, tb = 2 * pr + 1;
            u32x4 pw; pw.x = cvt_pk_bf16(sc[ta][0] * inv, sc[ta][1] * inv); pw.y = cvt_pk_bf16(sc[ta][2] * inv, sc[ta][3] * inv);
            if (tb < 9) { pw.z = cvt_pk_bf16(sc[tb < 9 ? tb : 8][0] * inv, sc[tb < 9 ? tb : 8][1] * inv); pw.w = cvt_pk_bf16(sc[tb < 9 ? tb : 8][2] * inv, sc[tb < 9 ? tb : 8][3] * inv); }
            else { pw.z = 0u; pw.w = 0u; }
            const bf16x8 pa = as_bf16x8(pw);
#pragma unroll
            for (int dt = 0; dt < 4; ++dt) {
                const LAS bf16_t* vp = Vt + (dt * 16 + l15) * 264 + (kt0 + ta) * 16 + g4 * 4;
                u32x4 vw; const u32x2 va = *(const LAS u32x2*)vp; vw.x = va.x; vw.y = va.y;
                if (tb < 9) { const u32x2 vb = *(const LAS u32x2*)(vp + 16); vw.z = vb.x; vw.w = vb.y; } else { vw.z = 0u; vw.w = 0u; }
                o[dt] = MFMA16(pa, as_bf16x8(vw), o[dt]);
            }
        }
#pragma unroll
        for (int dt = 0; dt < 4; ++dt)
#pragma unroll
            for (int jj = 0; jj < 4; ++jj)
                YA[(size_t)(n * 128 + i0 + g4 * 4 + jj) * 1024 + hq * 64 + dt * 16 + l15] = f2bf(o[dt][jj]);
    }
    __syncthreads();
}

#undef SWA_QLOAD
__device__ __forceinline__ void gla_bcum(const bf16_t* P, const float* wgate, const float* bgate, int n, int h, LAS float* bc, LAS float* glr_s, LAS float* wg_s) {
    const int tid = otid();
    if (tid < 128) { const int t = tid >> 1, r0 = (tid & 1) * 8;
        const u32x4 w = *(const u32x4*)(P + (size_t)(n * 64 + t) * NP + C_GLR + r0); float f[8]; unpack8(w, f);
#pragma unroll
        for (int i = 0; i < 8; ++i) glr_s[t * 16 + r0 + i] = f[i]; }
    { const int r = tid >> 5, d0 = (tid & 31) * 4; const f32x4 w = *(const f32x4*)(wgate + r * 512 + h * 128 + d0);
      *(LAS f32x4*)(wg_s + r * 128 + d0) = w; }
    __syncthreads();
    const int d = tid & 127, tq = tid >> 7;
    float wreg[16];
#pragma unroll
    for (int r = 0; r < 16; ++r) wreg[r] = wg_s[r * 128 + d];
    const float bias = bgate[h * 128 + d];
    float c = 0.f;
    for (int tt = 0; tt < 16; ++tt) { const int t = tq * 16 + tt;
        float z = bias;
#pragma unroll
        for (int r = 0; r < 16; r += 4) { const f32x4 gv = *(const LAS f32x4*)(glr_s + t * 16 + r); z += gv[0] * wreg[r] + gv[1] * wreg[r + 1] + gv[2] * wreg[r + 2] + gv[3] * wreg[r + 3]; }
        const float ls = fminf(z, 0.f) - __logf(1.0f + __expf(-fabsf(z)));
        c += ls * (1.0f / 16.0f);
        bc[t * 128 + d] = c; }
    __syncthreads();
    float off = 0.f;
    for (int q = 0; q < tq; ++q) off += bc[(q * 16 + 15) * 128 + d];
    __syncthreads();
    if (tq > 0) { for (int tt = 0; tt < 16; ++tt) bc[(tq * 16 + tt) * 128 + d] += off; }
    __syncthreads();
}
__device__ __forceinline__ void gla_stage_vt(const bf16_t* P, int n, int h, LAS bf16_t* Vt) {
    const int tid = otid(), t = tid >> 3, e0 = (tid & 7) * 32;
    const bf16_t* vp = P + (size_t)(n * 64 + t) * NP + C_GV + h * 256 + e0;
#pragma unroll
    for (int q = 0; q < 4; ++q) { const u32x4 w = *(const u32x4*)(vp + q * 8); const int e = e0 + q * 8;
        Vt[(e + 0) * 72 + t] = (bf16_t)(w.x & 0xffffu); Vt[(e + 1) * 72 + t] = (bf16_t)(w.x >> 16);
        Vt[(e + 2) * 72 + t] = (bf16_t)(w.y & 0xffffu); Vt[(e + 3) * 72 + t] = (bf16_t)(w.y >> 16);
        Vt[(e + 4) * 72 + t] = (bf16_t)(w.z & 0xffffu); Vt[(e + 5) * 72 + t] = (bf16_t)(w.z >> 16);
        Vt[(e + 6) * 72 + t] = (bf16_t)(w.w & 0xffffu); Vt[(e + 7) * 72 + t] = (bf16_t)(w.w >> 16); }
}

__device__ __forceinline__ void gla_store_vt(const u32x4 (&rv)[4], int t, int e0, LAS bf16_t* Vt) {
#pragma unroll
    for (int q = 0; q < 4; ++q) { const u32x4 w = rv[q]; const int e = e0 + q * 8;
        Vt[(e + 0) * 72 + t] = (bf16_t)(w.x & 0xffffu); Vt[(e + 1) * 72 + t] = (bf16_t)(w.x >> 16);
        Vt[(e + 2) * 72 + t] = (bf16_t)(w.y & 0xffffu); Vt[(e + 3) * 72 + t] = (bf16_t)(w.y >> 16);
        Vt[(e + 4) * 72 + t] = (bf16_t)(w.z & 0xffffu); Vt[(e + 5) * 72 + t] = (bf16_t)(w.z >> 16);
        Vt[(e + 6) * 72 + t] = (bf16_t)(w.w & 0xffffu); Vt[(e + 7) * 72 + t] = (bf16_t)(w.w >> 16); }
}

__device__ __forceinline__ void gla_pass1_item(const Params& p, int l, int n, int h, LAS unsigned char* lds) {
    const int tid = otid(), lane = tid & 63, wid = tid >> 6, l15 = lane & 15, g4 = lane >> 4;
    const bf16_t* P = (const bf16_t*)(p.ws + WS_P);
    LAS float* bc = (LAS float*)lds;
    LAS bf16_t* KdT = (LAS bf16_t*)(lds + 32768);
    LAS bf16_t* Vt = (LAS bf16_t*)(lds + 51200);
    LAS float* glr_s = (LAS float*)(lds + 88064);
    LAS float* wg_s = (LAS float*)(lds + 92160);
    const int st = tid >> 3, sd0 = (tid & 7) * 16, se0 = (tid & 7) * 32;
    const bf16_t* rowp = P + (size_t)(n * 64 + st) * NP;
    u32x4 rk[2], rv[4];
#pragma unroll
    for (int q = 0; q < 2; ++q) rk[q] = *(const u32x4*)(rowp + C_GK + h * 128 + sd0 + q * 8);
#pragma unroll
    for (int q = 0; q < 4; ++q) rv[q] = *(const u32x4*)(rowp + C_GV + h * 256 + se0 + q * 8);
    gla_bcum(P, kin(14) + (size_t)l * 16 * 512, kin(15) + (size_t)l * 512, n, h, bc, glr_s, wg_s);
    if (tid < 128) ((float*)(p.ws + WS_GDEC))[(size_t)(n * 4 + h) * 128 + tid] = __expf(bc[63 * 128 + tid]);
#pragma unroll
    for (int q = 0; q < 2; ++q) { float f[8]; unpack8(rk[q], f);
#pragma unroll
        for (int i = 0; i < 8; ++i) { const int d = sd0 + q * 8 + i; KdT[d * 72 + st] = f2bf(f[i] * __expf(bc[63 * 128 + d] - bc[st * 128 + d])); } }
    gla_store_vt(rv, st, se0, Vt);
    __syncthreads();
    bf16_t* GS = (bf16_t*)(p.ws + WS_GS) + (size_t)(n * 4 + h) * 256 * 128;
#pragma unroll
    for (int ei = 0; ei < 2; ++ei) { const int et = wid * 2 + ei;
        bf16x8 vf[2];
#pragma unroll
        for (int ks = 0; ks < 2; ++ks) vf[ks] = *(const LAS bf16x8*)(Vt + (et * 16 + l15) * 72 + ks * 32 + g4 * 8);
#pragma unroll
        for (int dt = 0; dt < 8; ++dt) {
            f32x4 a = (f32x4){0.f, 0.f, 0.f, 0.f};
#pragma unroll
            for (int ks = 0; ks < 2; ++ks) { const bf16x8 kf = *(const LAS bf16x8*)(KdT + (dt * 16 + l15) * 72 + ks * 32 + g4 * 8);
                a = MFMA16(kf, vf[ks], a); }
            u32x2 w; w.x = cvt_pk_bf16(a[0], a[1]); w.y = cvt_pk_bf16(a[2], a[3]);
            *(u32x2*)(GS + (size_t)(et * 16 + l15) * 128 + dt * 16 + g4 * 4) = w;
        } }
    __syncthreads();
}

__device__ __forceinline__ void gla_pass3_item(const Params& p, int l, int n, int h, LAS unsigned char* lds) {
    const int tid = otid(), lane = tid & 63, wid = tid >> 6, l15 = lane & 15, g4 = lane >> 4;
    const bf16_t* P = (const bf16_t*)(p.ws + WS_P);
    LAS float* bc = (LAS float*)lds;
    LAS bf16_t* Gs = (LAS bf16_t*)lds;
    LAS bf16_t* Qs = (LAS bf16_t*)(lds + 32768);
    LAS bf16_t* Kn = (LAS bf16_t*)(lds + 50176);
    LAS bf16_t* Vt = (LAS bf16_t*)(lds + 67584);
    LAS bf16_t* At = (LAS bf16_t*)(lds + 104448);
    LAS float* glr_s = (LAS float*)(lds + 113664);
    LAS float* wg_s = (LAS float*)(lds + 117760);
    LAS float* ssq = (LAS float*)(lds + 125952);
    const int st = tid >> 3, sd0 = (tid & 7) * 16, se0 = (tid & 7) * 32;
    const bf16_t* rowp = P + (size_t)(n * 64 + st) * NP;
    u32x4 rq[2], rk[2], rv[4], rg[4];
#pragma unroll
    for (int q = 0; q < 2; ++q) { rq[q] = *(const u32x4*)(rowp + C_GQ + h * 128 + sd0 + q * 8); rk[q] = *(const u32x4*)(rowp + C_GK + h * 128 + sd0 + q * 8); }
#pragma unroll
    for (int q = 0; q < 4; ++q) { rv[q] = *(const u32x4*)(rowp + C_GV + h * 256 + se0 + q * 8); rg[q] = *(const u32x4*)(rowp + C_GOUT + h * 256 + se0 + q * 8); }
    gla_bcum(P, kin(14) + (size_t)l * 16 * 512, kin(15) + (size_t)l * 512, n, h, bc, glr_s, wg_s);
#pragma unroll
    for (int q = 0; q < 2; ++q) { float fq_[8], fk[8]; unpack8(rq[q], fq_); unpack8(rk[q], fk);
#pragma unroll
        for (int i = 0; i < 8; ++i) { const float b = bc[st * 128 + sd0 + q * 8 + i]; fq_[i] = fq_[i] * 0.08838834764831845f * __expf(b); fk[i] = fk[i] * __expf(-b); }
        *(LAS u32x4*)(Qs + st * 136 + sd0 + q * 8) = pack8(fq_); *(LAS u32x4*)(Kn + st * 136 + sd0 + q * 8) = pack8(fk); }
    gla_store_vt(rv, st, se0, Vt);
    __syncthreads();
    const bf16_t* GS = (const bf16_t*)(p.ws + WS_GST) + (size_t)(n * 4 + h) * 256 * 128;
    bf16x8 sf[2][4];
#pragma unroll
    for (int ei = 0; ei < 2; ++ei)
#pragma unroll
        for (int ks = 0; ks < 4; ++ks) sf[ei][ks] = *(const bf16x8*)(GS + (size_t)((wid * 2 + ei) * 16 + l15) * 128 + ks * 32 + g4 * 8);
    const float* ng = kin(16) + (size_t)l * 1024 + h * 256;
    float ngv[2];
#pragma unroll
    for (int ei = 0; ei < 2; ++ei) ngv[ei] = ng[(wid * 2 + ei) * 16 + l15];
#pragma unroll
    for (int q = 0; q < 4; ++q) *(LAS u32x4*)(Gs + st * 256 + se0 + q * 8) = rg[q];
#pragma unroll
    for (int ii = 0; ii < 2; ++ii) { const int id = wid * 2 + ii, ti = id >> 2, tj = id & 3;
        f32x4 a = (f32x4){0.f, 0.f, 0.f, 0.f};
        if (tj <= ti) {
#pragma unroll
            for (int ks = 0; ks < 4; ++ks) { const bf16x8 qf = *(const LAS bf16x8*)(Qs + (ti * 16 + l15) * 136 + ks * 32 + g4 * 8);
                const bf16x8 kf = *(const LAS bf16x8*)(Kn + (tj * 16 + l15) * 136 + ks * 32 + g4 * 8);
                a = MFMA16(qf, kf, a); }
            if (tj == ti) {
#pragma unroll
                for (int jj = 0; jj < 4; ++jj) if (g4 * 4 + jj < l15) a[jj] = 0.f; }
        }
#pragma unroll
        for (int jj = 0; jj < 4; ++jj) At[(ti * 16 + g4 * 4 + jj) * 72 + tj * 16 + l15] = f2bf(a[jj]); }
    __syncthreads();
    f32x4 o[2][4];
#pragma unroll
    for (int ei = 0; ei < 2; ++ei) { const int et = wid * 2 + ei;
        bf16x8 vf[2];
#pragma unroll
        for (int ks = 0; ks < 2; ++ks) vf[ks] = *(const LAS bf16x8*)(Vt + (et * 16 + l15) * 72 + ks * 32 + g4 * 8);
#pragma unroll
        for (int ti = 0; ti < 4; ++ti) {
            f32x4 a = (f32x4){0.f, 0.f, 0.f, 0.f};
#pragma unroll
            for (int ks = 0; ks < 4; ++ks) { const bf16x8 qf = *(const LAS bf16x8*)(Qs + (ti * 16 + l15) * 136 + ks * 32 + g4 * 8); a = MFMA16(qf, sf[ei][ks], a); }
#pragma unroll
            for (int ks = 0; ks < 2; ++ks) if (ks * 32 <= ti * 16 + 15) { const bf16x8 af = *(const LAS bf16x8*)(At + (ti * 16 + l15) * 72 + ks * 32 + g4 * 8); a = MFMA16(af, vf[ks], a); }
            o[ei][ti] = a;
        } }
#pragma unroll
    for (int ti = 0; ti < 4; ++ti)
#pragma unroll
        for (int jj = 0; jj < 4; ++jj) { float s = o[0][ti][jj] * o[0][ti][jj] + o[1][ti][jj] * o[1][ti][jj];
            s += __shfl_xor(s, 1); s += __shfl_xor(s, 2); s += __shfl_xor(s, 4); s += __shfl_xor(s, 8);
            if (l15 == 0) ssq[wid * 64 + ti * 16 + g4 * 4 + jj] = s; }
    __syncthreads();
    bf16_t* YG = (bf16_t*)(p.ws + WS_YG);
#pragma unroll
    for (int ti = 0; ti < 4; ++ti)
#pragma unroll
        for (int jj = 0; jj < 4; ++jj) { const int t = ti * 16 + g4 * 4 + jj;
            float tot = 0.f;
#pragma unroll
            for (int w = 0; w < 8; ++w) tot += ssq[w * 64 + t];
            const float rs = __builtin_amdgcn_rsqf(tot * (1.0f / 256.0f) + EPS);
#pragma unroll
            for (int ei = 0; ei < 2; ++ei) { const int e = (wid * 2 + ei) * 16 + l15;
                const float gt = bf2f(Gs[t * 256 + e]);
                const float v = o[ei][ti][jj] * rs * ngv[ei] * (gt * sigmoidf_(gt));
                YG[(size_t)(n * 64 + t) * 1024 + h * 256 + e] = f2bf(v); } }
    __syncthreads();
}

template <bool FINAL>
__device__ __forceinline__ void s5_pass(const Params& p, int l, LAS unsigned char* lds) {
    const int tid = otid(), lane = tid & 63, wid = tid >> 6, l15 = lane & 15, g4 = lane >> 4;
    bf16_t* P = (bf16_t*)(p.ws + WS_P);
    LAS float* X = (LAS float*)(lds + wid * 12800);
    LAS bf16_t* H = (LAS bf16_t*)(lds + wid * 12800 + 8448);
    const int bid_ = obid();
    const int g = (bid_ & 15) * 4 + (wid & 3), nb = (bid_ >> 4) * 2 + (wid >> 2);
    const bf16_t* bb = (const bf16_t*)(p.ws + WS_BB) + (size_t)g * 128 * 16;
    bf16x8 bf[8];
#pragma unroll
    for (int pt = 0; pt < 8; ++pt) { u32x4 w = (u32x4){0u, 0u, 0u, 0u}; if (g4 < 2) w = *(const u32x4*)(bb + (pt * 16 + l15) * 16 + g4 * 8); bf[pt] = as_bf16x8(w); }
    const f32x2 A = ((const f32x2*)(p.ws + WS_SA))[g * 64 + lane];
    bf16x8 cf[4], idB; float dsk = 0.f;
    if (FINAL) { const bf16_t* cc = (const bf16_t*)(p.ws + WS_CC) + (size_t)g * 16 * 128;
#pragma unroll
        for (int ks = 0; ks < 4; ++ks) cf[ks] = *(const bf16x8*)(cc + l15 * 128 + ks * 32 + g4 * 8);
        dsk = kin(10)[(size_t)l * 1024 + g * 16 + l15];
        unsigned e[8];
#pragma unroll
        for (int j = 0; j < 8; ++j) e[j] = (g4 * 8 + j == l15) ? 0x3F80u : 0u;
        u32x4 w; w.x = e[0] | (e[1] << 16); w.y = e[2] | (e[3] << 16); w.z = e[4] | (e[5] << 16); w.w = e[6] | (e[7] << 16);
        idB = as_bf16x8(w); }
    f32x2* S5C = (f32x2*)(p.ws + WS_S5C);
    const f32x2* S5S = (const f32x2*)(p.ws + WS_S5S);
    const bf16_t* ubase = P + (size_t)l15 * NP + C_U + g * 16 + g4 * 8;
#define S5_TROW(q) ((size_t)(nb + 32 * ((q) >> 2)) * 64 + (size_t)(((q) & 3) * 16))
    u32x4 unext = (u32x4){0u, 0u, 0u, 0u};
    if (g4 < 2) unext = *(const u32x4*)(ubase + S5_TROW(0) * NP);
    f32x2 s0next = (f32x2){0.f, 0.f};
    if (FINAL) s0next = S5S[((size_t)nb * 64 + g) * 64 + lane];
    float sr = 0.f, si = 0.f;
    for (int q = 0; q < 32; ++q) {
        const size_t trow = S5_TROW(q);
        const int n = nb + 32 * (q >> 2);
        const bf16x8 ua = as_bf16x8(unext);
        if (q + 1 < 32) { u32x4 t = (u32x4){0u, 0u, 0u, 0u}; if (g4 < 2) t = *(const u32x4*)(ubase + S5_TROW(q + 1) * NP); unext = t; }
        if ((q & 3) == 0) { sr = FINAL ? s0next.x : 0.f; si = FINAL ? s0next.y : 0.f;
            if (FINAL && q + 4 < 32) s0next = S5S[((size_t)(n + 32) * 64 + g) * 64 + lane]; }
#pragma unroll
        for (int pt = 0; pt < 8; ++pt) { f32x4 d = (f32x4){0.f, 0.f, 0.f, 0.f}; d = MFMA16(ua, bf[pt], d);
#pragma unroll
            for (int jj = 0; jj < 4; ++jj) X[(g4 * 4 + jj) * 132 + pt * 16 + l15] = d[jj]; }
        f32x4 uD = (f32x4){0.f, 0.f, 0.f, 0.f};
        if (FINAL) uD = MFMA16(ua, idB, uD);
        LDS_FENCE();
#pragma unroll
        for (int t = 0; t < 16; ++t) { const float xr = X[t * 132 + lane], xi = X[t * 132 + 64 + lane];
            cplx_step(A, sr, si, xr, xi);
            if (FINAL) { H[t * 136 + lane] = f2bf(sr); H[t * 136 + 64 + lane] = f2bf(si); } }
        LDS_FENCE();
        if (FINAL) {
            f32x4 y = (f32x4){0.f, 0.f, 0.f, 0.f};
#pragma unroll
            for (int ks = 0; ks < 4; ++ks) { const bf16x8 hf = *(const LAS bf16x8*)(H + l15 * 136 + ks * 32 + g4 * 8); y = MFMA16(hf, cf[ks], y); }
#pragma unroll
            for (int jj = 0; jj < 4; ++jj) {
                const float yv = y[jj] + dsk * uD[jj];
                const float inner = 0.7978845608028654f * (yv + 0.044715f * yv * yv * yv);
                const float z = yv * sigmoidf_(2.0f * inner);
                P[(trow + g4 * 4 + jj) * NP + C_AQ + g * 16 + l15] = f2bf(z); }
            LDS_FENCE();
        }
        if (!FINAL && (q & 3) == 3) S5C[((size_t)n * 64 + g) * 64 + lane] = (f32x2){sr, si};
    }
#undef S5_TROW
}

__device__ __forceinline__ void phase_scan(const Params& p) {
    const int tid = otid(), lane = tid & 63, wid = tid >> 6;
    const int gw = wid * gridDim.x + obid();
    if (gw < 1024) {
        const int idx = gw * 64 + lane, h = idx >> 14, e = (idx >> 6) & 255, dp = idx & 63;
        const unsigned* gs = (const unsigned*)(p.ws + WS_GS) + ((size_t)(h * 256 + e) * 128 + dp * 2) / 2;
        unsigned* gst = (unsigned*)(p.ws + WS_GST) + ((size_t)(h * 256 + e) * 128 + dp * 2) / 2;
        const f32x2* dec = (const f32x2*)(p.ws + WS_GDEC) + ((size_t)h * 128 + dp * 2) / 2;
        float s0 = 0.f, s1 = 0.f;
        unsigned un[16]; f32x2 dn[16];
#pragma unroll
        for (int j = 0; j < 16; ++j) { un[j] = gs[(size_t)j * (4 * 256 * 128 / 2)]; dn[j] = dec[(size_t)j * (4 * 128 / 2)]; }
        for (int n0 = 0; n0 < 256; n0 += 16) {
            unsigned u[16]; f32x2 dc[16];
#pragma unroll
            for (int j = 0; j < 16; ++j) { u[j] = un[j]; dc[j] = dn[j]; }
            if (n0 + 16 < 256) {
#pragma unroll
                for (int j = 0; j < 16; ++j) { un[j] = gs[(size_t)(n0 + 16 + j) * (4 * 256 * 128 / 2)]; dn[j] = dec[(size_t)(n0 + 16 + j) * (4 * 128 / 2)]; } }
#pragma unroll
            for (int j = 0; j < 16; ++j) { gst[(size_t)(n0 + j) * (4 * 256 * 128 / 2)] = cvt_pk_bf16(s0, s1);
                s0 = dc[j].x * s0 + bflo(u[j]); s1 = dc[j].y * s1 + bfhi(u[j]); }
        }
    } else if (gw < 1088) {
        const int g = gw - 1024;
        const f32x2 A = ((const f32x2*)(p.ws + WS_SA64))[g * 64 + lane];
        const f32x2* sc = (const f32x2*)(p.ws + WS_S5C) + (size_t)g * 64 + lane;
        f32x2* ss = (f32x2*)(p.ws + WS_S5S) + (size_t)g * 64 + lane;
        float sr = 0.f, si = 0.f;
        for (int n0 = 0; n0 < 256; n0 += 32) {
            f32x2 e[32];
#pragma unroll
            for (int j = 0; j < 32; ++j) e[j] = sc[(size_t)(n0 + j) * 4096];
#pragma unroll
            for (int j = 0; j < 32; ++j) { ss[(size_t)(n0 + j) * 4096] = (f32x2){sr, si};
                cplx_step(A, sr, si, e[j].x, e[j].y); }
        }
    }
}

constexpr int N_PHASES = 20;
__device__ __forceinline__ void run_phase(const Params& p, LAS unsigned char* lds, const int ph) {
    unsigned char* ws = p.ws;
    bf16_t* P = (bf16_t*)(ws + WS_P);
    bf16_t* HB = (bf16_t*)(ws + WS_HB);
    bf16_t* XB2 = (bf16_t*)(ws + WS_YA);
    float* RSS = (float*)(ws + WS_RSS);
    if (ph == 19) { phase_norm<false>(p.out, kin(24), nullptr, p.out); return; }
    const int l = (ph >= 10) ? 1 : 0, s = (ph >= 10) ? ph - 10 : ph;
    const int step = (l == 0) ? s : s + 1;
    const float* xin = (l == 0) ? kin(0) : p.out;
    switch (step) {
    case 0: {
        phase_conv<false>(p, 0, lds);
        phase_xb(kin(0), HB, RSS);
    } break;
    case 1: {
        pg8::Gemm g{HB, (const bf16_t*)(ws + WS_WIN), SEQ, NP, DM, DM};
        pg8::EpiProj E{P, RSS + (size_t)(l == 0 ? 0 : 2) * SEQ};
        pg8::gemm_phase(lds, g, E);
    } break;
    case 2: {
        for (int it = obid(); it < 512; it += gridDim.x) swa_item(P, (bf16_t*)(ws + WS_YA), (const float*)(ws + WS_ROPE), kin(13) + l * 16, it >> 2, it & 3, lds);
        for (int it = obid(); it < 1024; it += gridDim.x) gla_pass1_item(p, l, it >> 2, it & 3, lds);
        s5_pass<false>(p, l, lds);
    } break;
    case 3: phase_scan(p); break;
    case 4: {
        for (int it = obid(); it < 1024; it += gridDim.x) gla_pass3_item(p, l, it >> 2, it & 3, lds);
        s5_pass<true>(p, l, lds);
    } break;
    case 5: {
        __syncthreads();
        phase_conv<true>(p, l, lds);
        __syncthreads();
        pg8::Gemm g{P + C_AQ, (const bf16_t*)(ws + WS_WGLU), SEQ, 1024, 1024, NP};
        pg8::EpiGlu E{P, kin(12) + (size_t)l * 1024};
        pg8::gemm_phase(lds, g, E);
    } break;
    case 6: {
        for (int br = 0; br < 3; ++br) {
            const bf16_t* A = (br == 0) ? P + C_GQ : (const bf16_t*)(ws + (br == 1 ? WS_YA : WS_YG));
            const bf16_t* W = (const bf16_t*)(ws + (br == 0 ? WS_WBS : (br == 1 ? WS_WBA : WS_WBG)));
            pg8::Gemm g{A, W, SEQ, DM, 1024, (br == 0) ? NP : 1024};
            pg8::EpiBranch E{P, HB, br};
            pg8::gemm_phase(lds, g, E);
        }
    } break;
    case 7: {
        pg8::Gemm g{HB, (const bf16_t*)(ws + WS_WOUT), SEQ, DM, DM, DM};
        pg8::EpiResid E{xin, p.out, XB2, RSS + (size_t)(l == 0 ? 1 : 3) * SEQ};
        pg8::gemm_phase(lds, g, E);
    } break;
    case 8: {
        if (l == 0) { __syncthreads(); phase_conv<false>(p, 1, lds); __syncthreads(); }
        pg8::Gemm g{XB2, (const bf16_t*)(ws + WS_WFF1), SEQ, DFF, DM, DM};
        pg8::EpiRelu2 E{P, RSS + (size_t)(l == 0 ? 1 : 3) * SEQ};
        pg8::gemm_phase(lds, g, E);
#ifdef PROBE_FFN1
        if (l == 1) pg8::gemm_phase(lds, g, E);
#endif
    } break;
    default: {
        pg8::Gemm g{P, (const bf16_t*)(ws + WS_WFF2), SEQ, DM, DFF, DFF};
        pg8::EpiResid E{p.out, p.out, (l == 0) ? HB : nullptr, (l == 0) ? RSS + (size_t)2 * SEQ : nullptr};
        pg8::gemm_phase(lds, g, E);
    } break;
    }
}


#define XB_XCNT(j)  (256  + 64 * (j))
#define XB_XSUB(j)  (1280 + 64 * (j))
#define XB_XGEN(j)  (2304 + 64 * (j))
#define XB_TOP      3328
#define XB_TOPGEN   3392
__device__ __forceinline__ unsigned xb_ld(unsigned* p)              { return __hip_atomic_load(p, __ATOMIC_RELAXED, __HIP_MEMORY_SCOPE_AGENT); }
__device__ __forceinline__ unsigned xb_add(unsigned* p, unsigned v) { return __hip_atomic_fetch_add(p, v, __ATOMIC_RELAXED, __HIP_MEMORY_SCOPE_AGENT); }
__device__ __forceinline__ unsigned xb_xcc_id() { return (unsigned)__builtin_amdgcn_s_getreg((3 << 11) | 20) & 0xFu; }
__device__ __forceinline__ void grid_barrier(unsigned* bar, const unsigned xcc, unsigned& nloc, unsigned& nx) {
    asm volatile("s_waitcnt vmcnt(0)" ::: "memory");
    __syncthreads();
    if (otid() == 0) {
        if (nloc == 0u) {
            const unsigned G = gridDim.x;
            for (;;) { unsigned sum = 0u, cnt = 0u, mine = 0u;
#pragma unroll
                for (unsigned j = 0; j < 16; ++j) { const unsigned c = xb_ld(&bar[XB_XCNT(j)]); sum += c; cnt += (c > 0u) ? 1u : 0u; mine = (j == xcc) ? c : mine; }
                if (sum == G) { nloc = mine; nx = cnt; break; }
                __builtin_amdgcn_s_sleep(1); } }
        const unsigned old = xb_add(&bar[XB_XSUB(xcc)], 1u);
        const unsigned gen = old / nloc;
        if (old + 1u == (gen + 1u) * nloc) {
            __builtin_amdgcn_fence(__ATOMIC_RELEASE, "agent");
            asm volatile("s_waitcnt vmcnt(0)" ::: "memory");
            const unsigned og = xb_add(&bar[XB_TOP], 1u);
            const unsigned tg = og / nx;
            if (og + 1u == (tg + 1u) * nx) xb_add(&bar[XB_TOPGEN], 1u);
            else while (xb_ld(&bar[XB_TOPGEN]) == tg) __builtin_amdgcn_s_sleep(1);
            __builtin_amdgcn_fence(__ATOMIC_ACQUIRE, "agent");
            xb_add(&bar[XB_XGEN(xcc)], 1u);
            asm volatile("s_waitcnt vmcnt(0)" ::: "memory");
        } else {
            while (xb_ld(&bar[XB_XGEN(xcc)]) == gen) __builtin_amdgcn_s_sleep(1);
            __builtin_amdgcn_fence(__ATOMIC_ACQUIRE, "agent");
            asm volatile("s_waitcnt vmcnt(0)" ::: "memory");
        }
    }
    __syncthreads();
}
#define MK_PHASE(k) if (p.ph_lo <= (k) && (k) < p.ph_hi) { if ((k) > p.ph_lo) { if ((k) == 1) cg::this_grid().sync(); grid_barrier(xbar, xcc, xb_nloc, xb_nx); } run_phase(p, lds, (k)); }
__global__ void __launch_bounds__(512, 2) mega(Params p) {
    extern __shared__ __attribute__((aligned(16))) unsigned char shm_[];
    LAS unsigned char* lds = (LAS unsigned char*)shm_;
    unsigned* xbar = (unsigned*)(p.ws + WS_END);
    const unsigned xcc = xb_xcc_id();
    unsigned xb_nloc = 0u, xb_nx = 0u;
    if (p.ph_hi - p.ph_lo > 1 && otid() == 0) (void)xb_add(&xbar[XB_XCNT(xcc)], 1u);
    MK_PHASE(0) MK_PHASE(1) MK_PHASE(2) MK_PHASE(3) MK_PHASE(4) MK_PHASE(5) MK_PHASE(6) MK_PHASE(7) MK_PHASE(8) MK_PHASE(9) MK_PHASE(10)
    MK_PHASE(11) MK_PHASE(12) MK_PHASE(13) MK_PHASE(14) MK_PHASE(15) MK_PHASE(16) MK_PHASE(17) MK_PHASE(18) MK_PHASE(19)
    if (DBG_STOP >= 0 && !MK_LAUNCH_PER_PHASE) {
        cg::this_grid().sync();
        __builtin_amdgcn_fence(__ATOMIC_ACQUIRE, "agent");
        const unsigned* w = (const unsigned*)p.ws; const size_t nwords = WS_END / 4, nout = (size_t)SEQ * DM;
        for (size_t i = (size_t)obid() * 512 + otid(); i < nout; i += (size_t)gridDim.x * 512) {
            float s = 0.f;
            for (size_t j = i; j < nwords; j += nout) { const unsigned v = w[j]; s += (float)((v >> 16) ^ (v & 0xffffu)); }
            p.out[i] = s * (1.0f / 65536.0f);
        }
    }
}


__global__ void dbg_digest(const unsigned* w, float* out, size_t nwords, size_t nout) {
    for (size_t i = (size_t)blockIdx.x * blockDim.x + threadIdx.x; i < nout; i += (size_t)gridDim.x * blockDim.x) {
        float s = 0.f;
        for (size_t j = i; j < nwords; j += nout) { const unsigned v = w[j]; s += (float)((v >> 16) ^ (v & 0xffffu)); }
        out[i] = s * (1.0f / 65536.0f);
    }
}
extern "C" void kernel_launch(void* const* d_in, const int* in_sizes, int n_in, void* d_out, int out_size, void* d_ws, size_t ws_size, hipStream_t stream) {
    static int ready = 0;
    if (!ready) {
        if (n_in != 25 || out_size != SEQ * DM || ws_size < WS_TOTAL) { fprintf(stderr, "kernel_launch: unexpected shapes (n_in %d out %d ws %zu need %zu)\n", n_in, out_size, ws_size, (size_t)WS_END); ready = -1; return; }
        if (hipFuncSetAttribute((const void*)mega, hipFuncAttributeMaxDynamicSharedMemorySize, LDS_BYTES) != hipSuccess) { fprintf(stderr, "kernel_launch: hipFuncSetAttribute failed\n"); ready = -1; return; }
        ready = 1;
    }
    if (ready < 0) return;
    Params p{};
    for (int i = 0; i < 25; ++i) p.in[i] = (const float*)d_in[i];
    p.out = (float*)d_out; p.ws = (unsigned char*)d_ws;
#if MK_LAUNCH_PER_PHASE
    for (int ph = 0; ph < (DBG_STOP >= 0 ? DBG_STOP + 1 : N_PHASES); ++ph) {
        p.ph_lo = ph; p.ph_hi = ph + 1;
        hipLaunchKernelGGL(mega, dim3(256), dim3(512), LDS_BYTES, stream, p);
    }
    if (DBG_STOP >= 0) hipLaunchKernelGGL(dbg_digest, dim3(2048), dim3(256), 0, stream, (const unsigned*)d_ws, (float*)d_out, (size_t)(WS_END / 4), (size_t)SEQ * DM);
#else
    p.ph_lo = 0; p.ph_hi = (DBG_STOP >= 0) ? DBG_STOP + 1 : N_PHASES;
    hipMemsetAsync((unsigned char*)d_ws + WS_END, 0, WS_TOTAL - WS_END, stream);
    void* args[] = {&p};
    hipError_t e = hipLaunchCooperativeKernel((const void*)mega, dim3(256), dim3(512), args, LDS_BYTES, stream);
    if (e != hipSuccess) fprintf(stderr, "cooperative launch failed: %s\n", hipGetErrorString(e));
#endif
}
```

```cpp
#include <hip/hip_runtime.h>
#include <hip/hip_cooperative_groups.h>
#include <cstdio>
namespace cg = cooperative_groups;

#ifndef DBG_STOP
#define DBG_STOP -1
#endif
#ifndef MK_LAUNCH_PER_PHASE
#define MK_LAUNCH_PER_PHASE 0
#endif

#ifndef P2MASK
#define P2MASK 7
#endif
#ifndef PHMASK
#define PHMASK 0xfff
#endif
#define PH_ON(k) ((PHMASK >> (k)) & 1)
#define LAS __attribute__((address_space(3)))
typedef unsigned short bf16_t;
typedef short bf16x8 __attribute__((ext_vector_type(8)));
typedef float f32x4 __attribute__((ext_vector_type(4)));
typedef float f32x2 __attribute__((ext_vector_type(2)));
typedef unsigned u32x4 __attribute__((ext_vector_type(4)));
typedef unsigned u32x2 __attribute__((ext_vector_type(2)));

constexpr int SEQ = 16384, DM = 2048, DFF = 8192, NP = 12032;
constexpr int C_U = 0, C_AQ = 1024, C_AK = 2048, C_AV = 2304, C_GQ = 2560, C_GK = 3072, C_GV = 3584, C_GOUT = 4608, C_MERGE = 5632, C_GLR = 11776;
constexpr int IN_W = 11792;
constexpr float EPS = 1e-6f;

constexpr size_t WS_WIN = 0;
constexpr size_t WS_WGLU = WS_WIN + (size_t)NP * DM * 2;
constexpr size_t WS_WBS = WS_WGLU + (size_t)1024 * 1024 * 2;
constexpr size_t WS_WBA = WS_WBS + (size_t)2048 * 1024 * 2;
constexpr size_t WS_WBG = WS_WBA + (size_t)2048 * 1024 * 2;
constexpr size_t WS_WOUT = WS_WBG + (size_t)2048 * 1024 * 2;
constexpr size_t WS_WFF1 = WS_WOUT + (size_t)2048 * 2048 * 2;
constexpr size_t WS_WFF2 = WS_WFF1 + (size_t)DFF * DM * 2;
constexpr size_t WS_P = WS_WFF2 + (size_t)DFF * DM * 2;
constexpr size_t WS_HB = WS_P + (size_t)SEQ * NP * 2;
constexpr size_t WS_GS = WS_HB + (size_t)SEQ * DM * 2;
constexpr size_t WS_GDEC = WS_GS + (size_t)256 * 4 * 256 * 128 * 2;
constexpr size_t WS_S5C = WS_GDEC + (size_t)256 * 4 * 128 * 4;
constexpr size_t WS_SA = WS_S5C + (size_t)256 * 64 * 64 * 8;
constexpr size_t WS_SA64 = WS_SA + (size_t)64 * 64 * 8;
constexpr size_t WS_BB = WS_SA64 + (size_t)64 * 64 * 8;
constexpr size_t WS_CC = WS_BB + (size_t)64 * 128 * 16 * 2;
constexpr size_t WS_ROPE = WS_CC + (size_t)64 * 16 * 128 * 2;
constexpr size_t WS_YA = WS_ROPE + (size_t)SEQ * 64 * 4;
constexpr size_t WS_YG = WS_YA + (size_t)SEQ * 1024 * 2;
constexpr size_t WS_S5S = WS_YG + (size_t)SEQ * 1024 * 2;
constexpr size_t WS_END = WS_S5S + (size_t)256 * 64 * 64 * 8;
constexpr size_t WS_GST = WS_WFF1;

constexpr size_t WS_RSS = WS_END + 16384;
constexpr size_t WS_TOTAL = WS_RSS + (size_t)4 * SEQ * 4;
constexpr int LDS_BYTES = 131072;

struct Params { const float* in[25]; float* out; unsigned char* ws; int ph_lo, ph_hi; };

__device__ __forceinline__ int otid() { int t = __builtin_amdgcn_workitem_id_x(); asm volatile("" : "+v"(t)); return t; }
__device__ __forceinline__ int obid() { int b = __builtin_amdgcn_workgroup_id_x(); asm volatile("" : "+s"(b)); return b; }
typedef const float* cfptr;
__device__ __forceinline__ cfptr kin(int k) { asm volatile("" : "+s"(k)); const __attribute__((address_space(4))) cfptr* ka = (const __attribute__((address_space(4))) cfptr*)__builtin_amdgcn_kernarg_segment_ptr(); return ka[k]; }
typedef __bf16 bf16x2v __attribute__((ext_vector_type(2)));
__device__ __forceinline__ unsigned cvt_pk_bf16(float lo, float hi) { f32x2 v = {lo, hi}; bf16x2v r = __builtin_convertvector(v, bf16x2v); return __builtin_bit_cast(unsigned, r); }
__device__ __forceinline__ bf16_t f2bf(float f) { const __bf16 b = (__bf16)f; return __builtin_bit_cast(unsigned short, b); }
__device__ __forceinline__ float bflo(unsigned w) { return __uint_as_float(w << 16); }
__device__ __forceinline__ float bfhi(unsigned w) { return __uint_as_float(w & 0xffff0000u); }
__device__ __forceinline__ float bf2f(bf16_t b) { return __uint_as_float(((unsigned)b) << 16); }
__device__ __forceinline__ float sigmoidf_(float x) { return __builtin_amdgcn_rcpf(1.0f + __expf(-x)); }
__device__ __forceinline__ float wave_sum(float v) {
#pragma unroll
    for (int o = 1; o < 64; o <<= 1) v += __shfl_xor(v, o);
    return v;
}
__device__ __forceinline__ void unpack8(const u32x4 w, float (&f)[8]) {
    f[0] = bflo(w.x); f[1] = bfhi(w.x); f[2] = bflo(w.y); f[3] = bfhi(w.y); f[4] = bflo(w.z); f[5] = bfhi(w.z); f[6] = bflo(w.w); f[7] = bfhi(w.w);
}
__device__ __forceinline__ u32x4 pack8(const float (&f)[8]) {
    u32x4 w; w.x = cvt_pk_bf16(f[0], f[1]); w.y = cvt_pk_bf16(f[2], f[3]); w.z = cvt_pk_bf16(f[4], f[5]); w.w = cvt_pk_bf16(f[6], f[7]); return w;
}
__device__ __forceinline__ bf16x8 as_bf16x8(u32x4 w) { return __builtin_bit_cast(bf16x8, w); }
#ifndef REPMASK
#define REPMASK 0
#endif
#ifndef MFMA_PAD
#define MFMA_PAD 0
#endif
__device__ __forceinline__ f32x4 mfma16_pad(bf16x8 a, bf16x8 b, f32x4 c) {
    f32x4 d = __builtin_amdgcn_mfma_f32_16x16x32_bf16(a, b, c, 0, 0, 0);
#if MFMA_PAD
    asm volatile("s_nop 7\n\ts_nop 7\n\ts_nop 7" : "+v"(d));
#endif
    return d;
}
#define MFMA16(a, b, c) mfma16_pad((a), (b), (c))
#define LDS_FENCE() asm volatile("s_waitcnt lgkmcnt(0)" ::: "memory")

__device__ __forceinline__ void cplx_step(const f32x2 A, float& sr, float& si, const float xr, const float xi) {
    float t1 = __builtin_fmaf(-A.y, si, xr); asm volatile("" : "+v"(t1), "+v"(sr));
    float nr = __builtin_fmaf(A.x, sr, t1);  asm volatile("" : "+v"(nr), "+v"(sr), "+v"(si));
    float t2 = __builtin_fmaf(A.y, sr, xi);  asm volatile("" : "+v"(t2), "+v"(si));
    const float ni = __builtin_fmaf(A.x, si, t2);
    sr = nr; si = ni;
}
__device__ __forceinline__ void sincos_d(double x, double& s, double& c) {
    const double k = rint(x * 0.63661977236758134308);
    double r = fma(-k, 1.57079632679489655800e+00, x);
    r = fma(-k, 6.12323399573676603587e-17, r);
    const double r2 = r * r;
    double sp = 1.0 / 6227020800.0; sp = fma(sp, r2, -1.0 / 39916800.0); sp = fma(sp, r2, 1.0 / 362880.0); sp = fma(sp, r2, -1.0 / 5040.0); sp = fma(sp, r2, 1.0 / 120.0); sp = fma(sp, r2, -1.0 / 6.0);
    const double sr = fma(sp * r2, r, r);
    double cp = 1.0 / 479001600.0; cp = fma(cp, r2, -1.0 / 3628800.0); cp = fma(cp, r2, 1.0 / 40320.0); cp = fma(cp, r2, -1.0 / 720.0); cp = fma(cp, r2, 1.0 / 24.0); cp = fma(cp, r2, -0.5);
    const double cr = fma(cp, r2, 1.0);
    const int q = ((int)k) & 3;
    s = (q == 0) ? sr : (q == 1) ? cr : (q == 2) ? -sr : -cr;
    c = (q == 0) ? cr : (q == 1) ? -sr : (q == 2) ? -cr : sr;
}
__device__ __forceinline__ double exp_d(double x) {
    const double k = rint(x * 1.44269504088896340736);
    const double r = fma(-k, 6.93147180369123816490e-01, x) - k * 1.90821492927058770002e-10;
    double p = 1.0 / 6227020800.0;
    p = fma(p, r, 1.0 / 479001600.0); p = fma(p, r, 1.0 / 39916800.0); p = fma(p, r, 1.0 / 3628800.0); p = fma(p, r, 1.0 / 362880.0); p = fma(p, r, 1.0 / 40320.0);
    p = fma(p, r, 1.0 / 5040.0); p = fma(p, r, 1.0 / 720.0); p = fma(p, r, 1.0 / 120.0); p = fma(p, r, 1.0 / 24.0); p = fma(p, r, 1.0 / 6.0); p = fma(p, r, 0.5); p = fma(p, r, 1.0); p = fma(p, r, 1.0);
    return ldexp(p, (int)k);
}

namespace pg8 {
constexpr int BM = 256, BK = 64, HALF = 128, HTB = HALF * BK * 2, STAGE_BYTES = 8 * HTB, NXCD = 8, WGM = 8;
__device__ __forceinline__ int lds_byte(int r, int c) { const int st = (r >> 4) * 2 + (c >> 5), rr = r & 15, cc = c & 31, ob = rr * 64 + cc * 2; return st * 1024 + (ob ^ (((ob >> 9) & 1) << 5)); }
__device__ __forceinline__ void stage_rc(int b, int& R, int& C) { const int st = b / 1024, sb = b % 1024, swz = sb ^ (((sb >> 9) & 1) << 5); R = (st >> 1) * 16 + swz / 64; C = (st & 1) * 32 + (swz % 64) / 2; }
__device__ __forceinline__ int perm32(int rho) { const int n = rho >> 4, i = rho & 15; return 8 * (i >> 2) + 4 * n + (i & 3); }
struct Unit { int pm, pn; };
struct Gemm { const bf16_t* A; const bf16_t* Bt; int M, N, K, lda; };
struct StaticOrder {
    int nM, nN, nwg, G, c;
    __device__ void init(int M, int N, int G_, int c_) { nM = M / BM; nN = N / BM; nwg = nM * nN; G = G_; c = c_; }
    __device__ bool next(int i, Unit& u) const {
        const long L = (long)i * G + c; if (L >= nwg) return false;
        int wgid = (int)L; { const int q = nwg / NXCD, r = nwg % NXCD, xcd = wgid % NXCD, off = wgid / NXCD; wgid = (xcd < r ? xcd * (q + 1) : r * (q + 1) + (xcd - r) * q) + off; }
        const int nig = WGM * nN, gid = wgid / nig, fm = gid * WGM, gsz = (nM - fm) < WGM ? (nM - fm) : WGM;
        u.pm = fm + ((wgid % nig) % gsz); u.pn = (wgid % nig) / gsz; return true;
    }
};

template <class Epi>
__device__ __forceinline__ void gemm_phase(LAS unsigned char* lds, const Gemm g, const Epi& E) {
    const int tid = otid(), wid = __builtin_amdgcn_readfirstlane(tid >> 6), lane = tid & 63, wr = wid >> 2, wc = wid & 3, fr = lane & 15, fq = lane >> 4;
    const int K = g.K, nt = K / BK, lda = g.lda;
    unsigned voffA[2], voffB[2];
#pragma unroll
    for (int i = 0; i < 2; ++i) { int R, C; stage_rc(tid * 16 + i * 8192, R, C); const int Rb = Epi::PERM ? ((R & ~31) + perm32(R & 31)) : R;
        voffA[i] = (unsigned)(R * lda + C) * 2u; voffB[i] = (unsigned)(Rb * K + C) * 2u; }
    const size_t kstep = (size_t)(BK * 2);
    const size_t hstepA = (size_t)HALF * lda * 2, hstepB = (size_t)HALF * K * 2;
    const size_t tstepA = 2 * hstepA, tstepB = 2 * hstepB;
    const unsigned ldsw = (unsigned)wid * 1024u;
    const int aoff = lds_byte(wr * 64 + fr, fq * 8), boff = lds_byte(wc * 32 + fr, fq * 8);
#define PG8_SA(b, h) (((b) * 2 + (h)) * HTB)
#define PG8_SB(b, h) ((4 + (b) * 2 + (h)) * HTB)
#define PG8_STAGE(bufoff, gbase, voff) do { _Pragma("unroll") for (int _i = 0; _i < 2; ++_i) \
        __builtin_amdgcn_global_load_lds((const unsigned*)((const char*)(gbase) + (voff)[_i]), (LAS unsigned*)(lds + (bufoff) + ldsw + _i * 8192), 16, 0, 0); } while (0)
#define PG8_LDA(dst, b, h) do { _Pragma("unroll") for (int m = 0; m < 4; ++m) _Pragma("unroll") for (int k = 0; k < 2; ++k) dst[m][k] = *(const LAS bf16x8*)(lds + PG8_SA(b, h) + aoff + m * 2048 + k * 1024); } while (0)
#define PG8_LDB(dst, b, h) do { _Pragma("unroll") for (int n = 0; n < 2; ++n) _Pragma("unroll") for (int k = 0; k < 2; ++k) dst[n][k] = *(const LAS bf16x8*)(lds + PG8_SB(b, h) + boff + n * 2048 + k * 1024); } while (0)
#define PG8_MMA(ai, bj, At, Bt) do { __builtin_amdgcn_s_setprio(1); _Pragma("unroll") for (int m = 0; m < 4; ++m) _Pragma("unroll") for (int n = 0; n < 2; ++n) _Pragma("unroll") for (int k = 0; k < 2; ++k) \
        acc[ai][bj][m][n] = __builtin_amdgcn_mfma_f32_16x16x32_bf16(Bt[n][k], At[m][k], acc[ai][bj][m][n], 0, 0, 0); __builtin_amdgcn_s_setprio(0); } while (0)
#define PG8_WAIT_V(n) asm volatile("s_waitcnt vmcnt(" #n ")" ::: "memory")
#define PG8_WAIT_L(n) asm volatile("s_waitcnt lgkmcnt(" #n ")" ::: "memory")
#define PG8_BAR __builtin_amdgcn_s_barrier()
#define PG8_SCHED __builtin_amdgcn_sched_barrier(0)
    StaticOrder S; S.init(g.M, g.N, (int)gridDim.x, (int)obid());
    Unit cur, nxt; int ui = 0;
    if (!S.next(0, cur)) return;
    f32x4 acc[2][2][4][2];
#pragma unroll
    for (int a = 0; a < 2; ++a)
#pragma unroll
        for (int b = 0; b < 2; ++b)
#pragma unroll
            for (int m = 0; m < 4; ++m)
#pragma unroll
                for (int n = 0; n < 2; ++n) acc[a][b][m][n] = (f32x4){0.f, 0.f, 0.f, 0.f};
    bf16x8 At[4][2], B0[2][2], B1[2][2];
    const char* cA = (const char*)g.A + (size_t)cur.pm * tstepA; const char* cB = (const char*)g.Bt + (size_t)cur.pn * tstepB;
    PG8_STAGE(PG8_SB(0, 0), cB, voffB); PG8_STAGE(PG8_SA(0, 0), cA, voffA); PG8_STAGE(PG8_SB(0, 1), cB + hstepB, voffB); PG8_STAGE(PG8_SA(0, 1), cA + hstepA, voffA);
    if (wr == 1) PG8_BAR;
    PG8_WAIT_V(4); PG8_BAR;
    PG8_STAGE(PG8_SB(1, 0), cB + kstep, voffB); PG8_STAGE(PG8_SA(1, 0), cA + kstep, voffA); PG8_STAGE(PG8_SB(1, 1), cB + hstepB + kstep, voffB);
    PG8_WAIT_V(6); PG8_BAR;
    for (;;) {
        const bool has_next = S.next(ui + 1, nxt);
        const char* nA = has_next ? (const char*)g.A + (size_t)nxt.pm * tstepA : cA; const char* nB = has_next ? (const char*)g.Bt + (size_t)nxt.pn * tstepB : cB;
        for (int t = 0; t < nt; t += 2) {
            const bool last = (t == nt - 2);
            const char* a1 = cA + (size_t)(t + 1) * kstep;
            const char* a2 = last ? nA : cA + (size_t)(t + 2) * kstep; const char* b2 = last ? nB : cB + (size_t)(t + 2) * kstep;
            const char* a3 = a2 + kstep; const char* b3 = b2 + kstep;
            PG8_LDB(B0, 0, 0); PG8_SCHED; PG8_LDA(At, 0, 0); PG8_STAGE(PG8_SA(1, 1), a1 + hstepA, voffA);
            PG8_WAIT_L(8); PG8_BAR; PG8_WAIT_L(0); PG8_MMA(0, 0, At, B0); PG8_BAR; PG8_SCHED;
            PG8_LDB(B1, 0, 1); PG8_STAGE(PG8_SB(0, 0), b2, voffB);
            PG8_BAR; PG8_WAIT_L(0); PG8_MMA(0, 1, At, B1); PG8_BAR;
            PG8_LDA(At, 0, 1); PG8_STAGE(PG8_SA(0, 0), a2, voffA);
            PG8_BAR; PG8_WAIT_L(0); PG8_MMA(1, 0, At, B0); PG8_BAR; PG8_SCHED;
            PG8_STAGE(PG8_SB(0, 1), b2 + hstepB, voffB);
            PG8_WAIT_V(6); PG8_BAR; PG8_MMA(1, 1, At, B1); PG8_BAR;
            PG8_LDB(B0, 1, 0); PG8_SCHED; PG8_LDA(At, 1, 0); PG8_STAGE(PG8_SA(0, 1), a2 + hstepA, voffA);
            PG8_WAIT_L(8); PG8_BAR; PG8_WAIT_L(0); PG8_MMA(0, 0, At, B0); PG8_BAR; PG8_SCHED;
            PG8_LDB(B1, 1, 1); PG8_STAGE(PG8_SB(1, 0), b3, voffB);
            PG8_BAR; PG8_WAIT_L(0); PG8_MMA(0, 1, At, B1); PG8_BAR;
            PG8_LDA(At, 1, 1); PG8_STAGE(PG8_SA(1, 0), a3, voffA);
            PG8_BAR; PG8_WAIT_L(0); PG8_MMA(1, 0, At, B0); PG8_BAR; PG8_SCHED;
            PG8_STAGE(PG8_SB(1, 1), b3 + hstepB, voffB);
            PG8_WAIT_V(6); PG8_BAR; PG8_MMA(1, 1, At, B1); PG8_BAR;
        }
        E(acc, cur, wr, wc, fr, fq);
        if (!has_next) break;
#pragma unroll
        for (int a = 0; a < 2; ++a)
#pragma unroll
            for (int b = 0; b < 2; ++b)
#pragma unroll
                for (int m = 0; m < 4; ++m)
#pragma unroll
                    for (int n = 0; n < 2; ++n) acc[a][b][m][n] = (f32x4){0.f, 0.f, 0.f, 0.f};
        cur = nxt; cA = nA; cB = nB; ++ui;
    }
    PG8_WAIT_V(0);
    if (wr == 0) PG8_BAR;
    PG8_BAR;
#undef PG8_SA
#undef PG8_SB
#undef PG8_STAGE
#undef PG8_LDA
#undef PG8_LDB
#undef PG8_MMA
#undef PG8_WAIT_V
#undef PG8_WAIT_L
#undef PG8_BAR
#undef PG8_SCHED
}

struct EpiProj {
    static constexpr bool PERM = true;
    bf16_t* P; const float* rss;
    __device__ __forceinline__ void operator()(const f32x4 (&acc)[2][2][4][2], const Unit& u, int wr, int wc, int fr, int fq) const {
        const int row0 = u.pm * BM + wr * 64 + fr, col0 = u.pn * BM + wc * 32 + 8 * fq;
        const bool sg = (u.pn >= 22) && (u.pn < 46);
        float rsv[2][4];
#pragma unroll
        for (int ai = 0; ai < 2; ++ai)
#pragma unroll
            for (int m = 0; m < 4; ++m) rsv[ai][m] = rss[row0 + ai * HALF + m * 16];
#pragma unroll
        for (int ai = 0; ai < 2; ++ai)
#pragma unroll
            for (int m = 0; m < 4; ++m) { bf16_t* rowp = P + (size_t)(row0 + ai * HALF + m * 16) * NP + col0;
                const float rs = __builtin_amdgcn_rsqf(rsv[ai][m] * (1.0f / DM) + EPS);
#pragma unroll
                for (int bj = 0; bj < 2; ++bj) { f32x4 v0 = acc[ai][bj][m][0] * rs, v1 = acc[ai][bj][m][1] * rs;
                    if (sg) {
#pragma unroll
                        for (int j = 0; j < 4; ++j) { v0[j] = sigmoidf_(v0[j]); v1[j] = sigmoidf_(v1[j]); } }
                    u32x4 w; w.x = cvt_pk_bf16(v0[0], v0[1]); w.y = cvt_pk_bf16(v0[2], v0[3]); w.z = cvt_pk_bf16(v1[0], v1[1]); w.w = cvt_pk_bf16(v1[2], v1[3]);
                    *(u32x4*)(rowp + bj * HALF) = w; } }
    }
};
struct EpiGlu {
    static constexpr bool PERM = true;
    bf16_t* P; const float* bias;
    __device__ __forceinline__ void operator()(const f32x4 (&acc)[2][2][4][2], const Unit& u, int wr, int wc, int fr, int fq) const {
        const int row0 = u.pm * BM + wr * 64 + fr, col0 = u.pn * BM + wc * 32 + 8 * fq;
        f32x4 bv[2][2];
#pragma unroll
        for (int bj = 0; bj < 2; ++bj)
#pragma unroll
            for (int n = 0; n < 2; ++n) bv[bj][n] = *(const f32x4*)(bias + col0 + bj * HALF + 4 * n);
#pragma unroll
        for (int ai = 0; ai < 2; ++ai) {
            u32x4 zw[4][2];
#pragma unroll
            for (int m = 0; m < 4; ++m)
#pragma unroll
                for (int bj = 0; bj < 2; ++bj) zw[m][bj] = *(const u32x4*)(P + (size_t)(row0 + ai * HALF + m * 16) * NP + col0 + C_AQ + bj * HALF);
#pragma unroll
            for (int m = 0; m < 4; ++m) { bf16_t* rowp = P + (size_t)(row0 + ai * HALF + m * 16) * NP + col0;
#pragma unroll
                for (int bj = 0; bj < 2; ++bj) { const f32x4 v0 = acc[ai][bj][m][0] + bv[bj][0], v1 = acc[ai][bj][m][1] + bv[bj][1];
                    float z[8]; unpack8(zw[m][bj], z);
                    float o[8];
#pragma unroll
                    for (int j = 0; j < 4; ++j) { o[j] = z[j] * sigmoidf_(v0[j]); o[4 + j] = z[4 + j] * sigmoidf_(v1[j]); }
                    *(u32x4*)(rowp + C_GQ + bj * HALF) = pack8(o); } }
            asm volatile("" ::: "memory"); }
    }
};
struct EpiBranch {
    static constexpr bool PERM = true;
    const bf16_t* P; bf16_t* MX; int br;
    __device__ __forceinline__ void operator()(const f32x4 (&acc)[2][2][4][2], const Unit& u, int wr, int wc, int fr, int fq) const {
        const int row0 = u.pm * BM + wr * 64 + fr, col0 = u.pn * BM + wc * 32 + 8 * fq;
#pragma unroll
        for (int ai = 0; ai < 2; ++ai) {
            u32x4 gw[4][2], pw[4][2];
#pragma unroll
            for (int m = 0; m < 4; ++m)
#pragma unroll
                for (int bj = 0; bj < 2; ++bj) { const size_t r = (size_t)(row0 + ai * HALF + m * 16);
                    gw[m][bj] = *(const u32x4*)(P + r * NP + C_MERGE + br * 2048 + col0 + bj * HALF);
                    pw[m][bj] = (u32x4){0u, 0u, 0u, 0u};
                    if (br > 0) pw[m][bj] = *(const u32x4*)(MX + r * DM + col0 + bj * HALF); }
#pragma unroll
            for (int m = 0; m < 4; ++m) { const size_t r = (size_t)(row0 + ai * HALF + m * 16);
#pragma unroll
                for (int bj = 0; bj < 2; ++bj) { const f32x4 v0 = acc[ai][bj][m][0], v1 = acc[ai][bj][m][1];
                    float gt[8], pv[8]; unpack8(gw[m][bj], gt); unpack8(pw[m][bj], pv);
                    float o[8];
#pragma unroll
                    for (int j = 0; j < 4; ++j) { o[j] = pv[j] + gt[j] * v0[j]; o[4 + j] = pv[4 + j] + gt[4 + j] * v1[j]; }
                    *(u32x4*)(MX + r * DM + col0 + bj * HALF) = pack8(o); } }
            asm volatile("" ::: "memory"); }
    }
};
struct EpiResid {
    static constexpr bool PERM = false;
    const float* base; float* out; bf16_t* xb; float* rss;
    __device__ __forceinline__ void operator()(const f32x4 (&acc)[2][2][4][2], const Unit& u, int wr, int wc, int fr, int fq) const {
        const int row0 = u.pm * BM + wr * 64 + fr, col0 = u.pn * BM + wc * 32 + 4 * fq;
#pragma unroll
        for (int ai = 0; ai < 2; ++ai) {
            f32x4 bsv[4][2][2];
#pragma unroll
            for (int m = 0; m < 4; ++m)
#pragma unroll
                for (int bj = 0; bj < 2; ++bj)
#pragma unroll
                    for (int n = 0; n < 2; ++n) bsv[m][bj][n] = *(const f32x4*)(base + (size_t)(row0 + ai * HALF + m * 16) * DM + col0 + bj * HALF + n * 16);
#pragma unroll
            for (int m = 0; m < 4; ++m) { const size_t off = (size_t)(row0 + ai * HALF + m * 16) * DM + col0;
                float ss = 0.f;
#pragma unroll
                for (int bj = 0; bj < 2; ++bj)
#pragma unroll
                    for (int n = 0; n < 2; ++n) { const f32x4 o = bsv[m][bj][n] + acc[ai][bj][m][n];
                        *(f32x4*)(out + off + bj * HALF + n * 16) = o;
                        if (xb) { u32x2 w; w.x = cvt_pk_bf16(o[0], o[1]); w.y = cvt_pk_bf16(o[2], o[3]); *(u32x2*)(xb + off + bj * HALF + n * 16) = w;
                            ss += (o[0] * o[0] + o[1] * o[1]) + (o[2] * o[2] + o[3] * o[3]); } }
                if (xb) { ss += __shfl_xor(ss, 16); ss += __shfl_xor(ss, 32);
                    if (fq == 0) atomicAdd(rss + row0 + ai * HALF + m * 16, ss); } }
            asm volatile("" ::: "memory"); }
    }
};
struct EpiRelu2 {
    static constexpr bool PERM = true;
    bf16_t* H; const float* rss;
    __device__ __forceinline__ void operator()(const f32x4 (&acc)[2][2][4][2], const Unit& u, int wr, int wc, int fr, int fq) const {
        const int row0 = u.pm * BM + wr * 64 + fr, col0 = u.pn * BM + wc * 32 + 8 * fq;
        float rsv[2][4];
#pragma unroll
        for (int ai = 0; ai < 2; ++ai)
#pragma unroll
            for (int m = 0; m < 4; ++m) rsv[ai][m] = rss[row0 + ai * HALF + m * 16];
#pragma unroll
        for (int ai = 0; ai < 2; ++ai)
#pragma unroll
            for (int m = 0; m < 4; ++m) { bf16_t* rowp = H + (size_t)(row0 + ai * HALF + m * 16) * DFF + col0;
                const float rs = __builtin_amdgcn_rsqf(rsv[ai][m] * (1.0f / DM) + EPS);
#pragma unroll
                for (int bj = 0; bj < 2; ++bj) { f32x4 v0 = acc[ai][bj][m][0] * rs, v1 = acc[ai][bj][m][1] * rs;
#pragma unroll
                    for (int j = 0; j < 4; ++j) { const float a = fmaxf(v0[j], 0.f), b = fmaxf(v1[j], 0.f); v0[j] = a * a; v1[j] = b * b; }
                    u32x4 w; w.x = cvt_pk_bf16(v0[0], v0[1]); w.y = cvt_pk_bf16(v0[2], v0[3]); w.z = cvt_pk_bf16(v1[0], v1[1]); w.w = cvt_pk_bf16(v1[2], v1[3]);
                    *(u32x4*)(rowp + bj * HALF) = w; } }
    }
};
}

__device__ __forceinline__ void conv_tile(const float* src, int ldsrc, int K, bf16_t* dst, int k0, int n0, bool win, const float* gk, LAS bf16_t* T, int lane) {
    const int nl = (lane & 15) * 4, np = n0 + nl;
    int sc = np; bool valid = true;
    if (win) { if (np < 4608) sc = np; else if (np < 11776) sc = np + 16; else if (np < 11792) sc = np - 11776 + 4608; else valid = false; }
    f32x4 cv[16];
#pragma unroll
    for (int i = 0; i < 16; ++i) { cv[i] = (f32x4){0.f, 0.f, 0.f, 0.f}; if (valid) cv[i] = *(const f32x4*)(src + (size_t)(k0 + i * 4 + (lane >> 4)) * ldsrc + sc); }
    if (gk) {
#pragma unroll
        for (int i = 0; i < 16; ++i) cv[i] = cv[i] * gk[k0 + i * 4 + (lane >> 4)]; }
#pragma unroll
    for (int i = 0; i < 16; ++i) {
        const int kk = i * 4 + (lane >> 4);
        const f32x4 v = cv[i];
        T[(nl + 0) * 72 + kk] = f2bf(v[0]); T[(nl + 1) * 72 + kk] = f2bf(v[1]); T[(nl + 2) * 72 + kk] = f2bf(v[2]); T[(nl + 3) * 72 + kk] = f2bf(v[3]);
    }
    LDS_FENCE();
#pragma unroll
    for (int i = 0; i < 8; ++i) {
        const int n = i * 8 + (lane >> 3), c = lane & 7;
        const u32x4 w = *(const LAS u32x4*)(T + n * 72 + c * 8);
        *(u32x4*)(dst + (size_t)(n0 + n) * K + k0 + c * 8) = w;
    }
    LDS_FENCE();
}

template <bool FFN>
__device__ __forceinline__ void phase_conv(const Params& p, int l, LAS unsigned char* lds) {
    const int tid = otid(), lane = tid & 63, wid = tid >> 6;
    unsigned char* ws = p.ws;
    if (!FFN && obid() < 8) {
        const int gp = obid() * 512 + tid, g = gp >> 6, pp = gp & 63;
        const double lr = (double)kin(3)[(size_t)l * 4096 + gp], li = (double)kin(4)[(size_t)l * 4096 + gp];
        const double step = exp_d((double)kin(5)[l * 64 + g]);
        const double mag = exp_d(lr * step);
        double sn, cs; sincos_d(li * step, sn, cs);
        const double ar = mag * cs, ai = mag * sn, den = lr * lr + li * li;
        const double fr = ((ar - 1.0) * lr + ai * li) / den, fi = (ai * lr - (ar - 1.0) * li) / den;
        ((f32x2*)(ws + WS_SA))[gp] = (f32x2){(float)ar, (float)ai};
        double pr = ar, pi = ai;
#pragma unroll
        for (int i = 0; i < 6; ++i) { const double nr = pr * pr - pi * pi, ni = 2.0 * pr * pi; pr = nr; pi = ni; }
        ((f32x2*)(ws + WS_SA64))[gp] = (f32x2){(float)pr, (float)pi};
        const float* bre = kin(6) + ((size_t)l * 4096 + gp) * 16; const float* bim = kin(7) + ((size_t)l * 4096 + gp) * 16;
        bf16_t* bb = (bf16_t*)(ws + WS_BB) + (size_t)g * 128 * 16;
#pragma unroll
        for (int c = 0; c < 16; ++c) { const double br = bre[c], bi = bim[c];
            bb[pp * 16 + c] = f2bf((float)(fr * br - fi * bi)); bb[(64 + pp) * 16 + c] = f2bf((float)(fr * bi + fi * br)); }
        const float* cre = kin(8) + ((size_t)l * 64 + g) * 16 * 64; const float* cim = kin(9) + ((size_t)l * 64 + g) * 16 * 64;
        bf16_t* cc = (bf16_t*)(ws + WS_CC) + (size_t)g * 16 * 128;
#pragma unroll
        for (int c = 0; c < 16; ++c) { cc[c * 128 + pp] = f2bf(cre[c * 64 + pp]); cc[c * 128 + 64 + pp] = f2bf(-cim[c * 64 + pp]); }
    }
    if (!FFN && l == 0) {
        float* rt = (float*)(ws + WS_ROPE);
        for (int idx = obid() * 512 + tid; idx < SEQ * 32; idx += gridDim.x * 512) {
            const int pos = idx >> 5, i = idx & 31;
            const float inv = (float)exp_d(-(double)i * (9.21034037197618273607 / 32.0));
            const float ang = (float)pos * inv;
            double sn, cs; sincos_d((double)ang, sn, cs);
            rt[pos * 64 + i] = (float)cs; rt[pos * 64 + 32 + i] = (float)sn;
        }
    }
    LAS bf16_t* T = (LAS bf16_t*)(lds + wid * 9216);
    const int gw = wid * gridDim.x + obid(), nw = gridDim.x * 8;
    const int ntile[8] = {32 * 188, 16 * 16, 16 * 32, 16 * 32, 16 * 32, 32 * 32, 32 * 128, 128 * 32};
    int total = 0;
#pragma unroll
    for (int i = 0; i < 8; ++i) total += ntile[i];
    const int first6 = ntile[0] + ntile[1] + ntile[2] + ntile[3] + ntile[4] + ntile[5];
    for (int it = (FFN ? first6 : 0) + gw; it < (FFN ? total : first6); it += nw) {
        int r = it, mi = 0;
#pragma unroll
        for (int i = 0; i < 7; ++i) { if (mi == i && r >= ntile[i]) { r -= ntile[i]; mi = i + 1; } }
        const float* src; bf16_t* dst; int K, N, ldsrc; bool win = false; const float* gk = nullptr;
        switch (mi) {
            case 0: src = kin(2) + (size_t)l * DM * IN_W; dst = (bf16_t*)(ws + WS_WIN); K = DM; N = NP; ldsrc = IN_W; win = true; gk = kin(1) + (size_t)l * DM; break;
            case 1: src = kin(11) + (size_t)l * 1024 * 1024; dst = (bf16_t*)(ws + WS_WGLU); K = 1024; N = 1024; ldsrc = 1024; break;
            case 2: src = kin(17) + (size_t)l * 1024 * DM; dst = (bf16_t*)(ws + WS_WBS); K = 1024; N = DM; ldsrc = DM; break;
            case 3: src = kin(18) + (size_t)l * 1024 * DM; dst = (bf16_t*)(ws + WS_WBA); K = 1024; N = DM; ldsrc = DM; break;
            case 4: src = kin(19) + (size_t)l * 1024 * DM; dst = (bf16_t*)(ws + WS_WBG); K = 1024; N = DM; ldsrc = DM; break;
            case 5: src = kin(20) + (size_t)l * DM * DM; dst = (bf16_t*)(ws + WS_WOUT); K = DM; N = DM; ldsrc = DM; break;
            case 6: src = kin(22) + (size_t)l * DM * DFF; dst = (bf16_t*)(ws + WS_WFF1); K = DM; N = DFF; ldsrc = DFF; gk = kin(21) + (size_t)l * DM; break;
            default: src = kin(23) + (size_t)l * DFF * DM; dst = (bf16_t*)(ws + WS_WFF2); K = DFF; N = DM; ldsrc = DM; break;
        }
        const int nnt = N / 64, kt = r / nnt, ntl = r % nnt;
        conv_tile(src, ldsrc, K, dst, kt * 64, ntl * 64, win, gk, T, lane);
    }
}

template <bool TO_BF16>
__device__ __forceinline__ void phase_norm(const float* x, const float* g, bf16_t* hb, float* outf) {
    const int lane = otid() & 63, wid = otid() >> 6;
    const int gw = obid() * 8 + wid, nw = gridDim.x * 8;
    for (int row = gw; row < SEQ; row += nw) {
        const f32x4* xr = (const f32x4*)(x + (size_t)row * DM) + lane;
        f32x4 v[8]; float s = 0.f;
#pragma unroll
        for (int j = 0; j < 8; ++j) { v[j] = xr[64 * j]; s += (v[j][0] * v[j][0] + v[j][1] * v[j][1]) + (v[j][2] * v[j][2] + v[j][3] * v[j][3]); }
        s = wave_sum(s);
        const float rs = 1.0f / sqrtf(s * (1.0f / DM) + EPS);
#pragma unroll
        for (int j = 0; j < 8; ++j) {
            const f32x4 gv = *((const f32x4*)g + lane + 64 * j);
            const f32x4 o = v[j] * rs * gv;
            if (TO_BF16) { u32x2 w; w.x = cvt_pk_bf16(o[0], o[1]); w.y = cvt_pk_bf16(o[2], o[3]); *((u32x2*)(hb + (size_t)row * DM) + lane + 64 * j) = w; }
            else *((f32x4*)(outf + (size_t)row * DM) + lane + 64 * j) = o;
        }
    }
}

__device__ __forceinline__ void phase_xb(const float* x, bf16_t* xb, float* rss) {
    const int lane = otid() & 63, wid = otid() >> 6;
    const int gw = obid() * 8 + wid, nw = gridDim.x * 8;
    for (int row = gw; row < SEQ; row += nw) {
        const f32x4* xr = (const f32x4*)(x + (size_t)row * DM) + lane;
        f32x4 v[8]; float s = 0.f;
#pragma unroll
        for (int j = 0; j < 8; ++j) { v[j] = xr[64 * j]; s += (v[j][0] * v[j][0] + v[j][1] * v[j][1]) + (v[j][2] * v[j][2] + v[j][3] * v[j][3]); }
        s = wave_sum(s);
        if (lane == 0) rss[row] = s;
#pragma unroll
        for (int j = 0; j < 8; ++j) { u32x2 w; w.x = cvt_pk_bf16(v[j][0], v[j][1]); w.y = cvt_pk_bf16(v[j][2], v[j][3]); *((u32x2*)(xb + (size_t)row * DM) + lane + 64 * j) = w; }
    }
}

__device__ __forceinline__ void swa_item(const bf16_t* P, bf16_t* YA, const float* rope, const float* sinks, int n, int kvh, LAS unsigned char* lds) {
    const int tid = otid(), lane = tid & 63, wid = tid >> 6, l15 = lane & 15, g4 = lane >> 4;
    LAS bf16_t* Ks = (LAS bf16_t*)lds;
    LAS bf16_t* Vt = (LAS bf16_t*)(lds + 36864);
    {
        const int j = tid >> 1, hf = tid & 1, row = n * 128 - 128 + j;
        float o1[16], o2[16];
        if (row >= 0) {
            const bf16_t* kp = P + (size_t)row * NP + C_AK + kvh * 64 + hf * 16;
            const u32x4 a0 = *(const u32x4*)kp, a1 = *(const u32x4*)(kp + 8), b0 = *(const u32x4*)(kp + 32), b1 = *(const u32x4*)(kp + 40);
            float x1[16], x2[16];
            { float t[8]; unpack8(a0, t);
#pragma unroll
              for (int i = 0; i < 8; ++i) x1[i] = t[i]; unpack8(a1, t);
#pragma unroll
              for (int i = 0; i < 8; ++i) x1[8 + i] = t[i]; unpack8(b0, t);
#pragma unroll
              for (int i = 0; i < 8; ++i) x2[i] = t[i]; unpack8(b1, t);
#pragma unroll
              for (int i = 0; i < 8; ++i) x2[8 + i] = t[i]; }
            const float* rp = rope + (size_t)row * 64 + hf * 16;
#pragma unroll
            for (int i = 0; i < 16; i += 4) { const f32x4 c = *(const f32x4*)(rp + i), s = *(const f32x4*)(rp + 32 + i);
#pragma unroll
                for (int e = 0; e < 4; ++e) { o1[i + e] = x1[i + e] * c[e] - x2[i + e] * s[e]; o2[i + e] = x2[i + e] * c[e] + x1[i + e] * s[e]; } }
        } else {
#pragma unroll
            for (int i = 0; i < 16; ++i) { o1[i] = 0.f; o2[i] = 0.f; }
        }
        { float t[8];
#pragma unroll
          for (int i = 0; i < 8; ++i) t[i] = o1[i]; *(LAS u32x4*)(Ks + j * 72 + hf * 16) = pack8(t);
#pragma unroll
          for (int i = 0; i < 8; ++i) t[i] = o1[8 + i]; *(LAS u32x4*)(Ks + j * 72 + hf * 16 + 8) = pack8(t);
#pragma unroll
          for (int i = 0; i < 8; ++i) t[i] = o2[i]; *(LAS u32x4*)(Ks + j * 72 + 32 + hf * 16) = pack8(t);
#pragma unroll
          for (int i = 0; i < 8; ++i) t[i] = o2[8 + i]; *(LAS u32x4*)(Ks + j * 72 + 32 + hf * 16 + 8) = pack8(t); }
        const bf16_t* vp = P + (size_t)(row < 0 ? 0 : row) * NP + C_AV + kvh * 64 + hf * 32;
#pragma unroll
        for (int q = 0; q < 4; ++q) { u32x4 w = *(const u32x4*)(vp + q * 8); if (row < 0) w = (u32x4){0u, 0u, 0u, 0u};
            const int d0 = hf * 32 + q * 8;
            Vt[(d0 + 0) * 264 + j] = (bf16_t)(w.x & 0xffffu); Vt[(d0 + 1) * 264 + j] = (bf16_t)(w.x >> 16);
            Vt[(d0 + 2) * 264 + j] = (bf16_t)(w.y & 0xffffu); Vt[(d0 + 3) * 264 + j] = (bf16_t)(w.y >> 16);
            Vt[(d0 + 4) * 264 + j] = (bf16_t)(w.z & 0xffffu); Vt[(d0 + 5) * 264 + j] = (bf16_t)(w.z >> 16);
            Vt[(d0 + 6) * 264 + j] = (bf16_t)(w.w & 0xffffu); Vt[(d0 + 7) * 264 + j] = (bf16_t)(w.w >> 16); }
    }
    const int hq = kvh * 4 + (wid >> 1);
    const float sink = sinks[hq];
    u32x4 nw1, nw2; f32x4 nc0, nc1, ns0, ns1;
#define SWA_QLOAD(QT) do { const int qrow_ = n * 128 + (wid & 1) * 64 + (QT) * 16 + l15; const bf16_t* qp_ = P + (size_t)qrow_ * NP + C_AQ + hq * 64 + g4 * 8; \
        nw1 = *(const u32x4*)qp_; nw2 = *(const u32x4*)(qp_ + 32); const float* rp_ = rope + (size_t)qrow_ * 64 + g4 * 8; \
        nc0 = *(const f32x4*)rp_; nc1 = *(const f32x4*)(rp_ + 4); ns0 = *(const f32x4*)(rp_ + 32); ns1 = *(const f32x4*)(rp_ + 36); } while (0)
    SWA_QLOAD(0);
    __syncthreads();
    for (int qt = 0; qt < 4; ++qt) {
        const int i0 = (wid & 1) * 64 + qt * 16;
        bf16x8 qa0, qa1;
        {   const u32x4 w1 = nw1, w2 = nw2; const f32x4 c0 = nc0, c1 = nc1, s0 = ns0, s1 = ns1;
            if (qt + 1 < 4) SWA_QLOAD(qt + 1);
            float x1[8], x2[8], r1[8], r2[8]; unpack8(w1, x1); unpack8(w2, x2);
#pragma unroll
            for (int e = 0; e < 4; ++e) {
                r1[e] = (x1[e] * c0[e] - x2[e] * s0[e]) * 0.125f; r2[e] = (x2[e] * c0[e] + x1[e] * s0[e]) * 0.125f;
                r1[4 + e] = (x1[4 + e] * c1[e] - x2[4 + e] * s1[e]) * 0.125f; r2[4 + e] = (x2[4 + e] * c1[e] + x1[4 + e] * s1[e]) * 0.125f; }
            qa0 = as_bf16x8(pack8(r1)); qa1 = as_bf16x8(pack8(r2)); }
        const int kt0 = i0 >> 4;
        f32x4 sc[9];
#pragma unroll
        for (int t = 0; t < 9; ++t) {
            const LAS bf16_t* kp = Ks + ((kt0 + t) * 16 + l15) * 72 + g4 * 8;
            const bf16x8 k0 = *(const LAS bf16x8*)kp, k1 = *(const LAS bf16x8*)(kp + 32);
            f32x4 a = (f32x4){0.f, 0.f, 0.f, 0.f};
            a = MFMA16(k0, qa0, a); a = MFMA16(k1, qa1, a);
            sc[t] = a;
        }
        const int qi = i0 + l15;
        float mx = sink;
#pragma unroll
        for (int t = 0; t < 9; ++t)
#pragma unroll
            for (int jj = 0; jj < 4; ++jj) { const int j = (kt0 + t) * 16 + g4 * 4 + jj;
                const bool ok = (j > qi) && (j <= qi + 128) && (n * 128 - 128 + j >= 0);
                sc[t][jj] = ok ? sc[t][jj] : -INFINITY; mx = fmaxf(mx, sc[t][jj]); }
        mx = fmaxf(mx, __shfl_xor(mx, 16)); mx = fmaxf(mx, __shfl_xor(mx, 32));
        float sum = 0.f;
#pragma unroll
        for (int t = 0; t < 9; ++t)
#pragma unroll
            for (int jj = 0; jj < 4; ++jj) { const float e = __expf(sc[t][jj] - mx); sc[t][jj] = e; sum += e; }
        sum += __shfl_xor(sum, 16); sum += __shfl_xor(sum, 32);
        sum += __expf(sink - mx);
        const float inv = 1.0f / sum;
        f32x4 o[4];
#pragma unroll
        for (int dt = 0; dt < 4; ++dt) o[dt] = (f32x4){0.f, 0.f, 0.f, 0.f};
#pragma unroll
        for (int pr = 0; pr < 5; ++pr) {
            const int ta = 2 * pr, tb = 2 * pr + 1;
            u32x4 pw; pw.x = cvt_pk_bf16(sc[ta][0] * inv, sc[ta][1] * inv); pw.y = cvt_pk_bf16(sc[ta][2] * inv, sc[ta][3] * inv);
            if (tb < 9) { pw.z = cvt_pk_bf16(sc[tb < 9 ? tb : 8][0] * inv, sc[tb < 9 ? tb : 8][1] * inv); pw.w = cvt_pk_bf16(sc[tb < 9 ? tb : 8][2] * inv, sc[tb < 9 ? tb : 8][3] * inv); }
            else { pw.z = 0u; pw.w = 0u; }
            const bf16x8 pa = as_bf16x8(pw);
#pragma unroll
            for (int dt = 0; dt < 4; ++dt) {
                const LAS bf16_t* vp = Vt + (dt * 16 + l15) * 264 + (kt0 + ta) * 16 + g4 * 4;
                u32x4 vw; const u32x2 va = *(const LAS u32x2*)vp; vw.x = va.x; vw.y = va.y;
                if (tb < 9) { const u32x2 vb = *(const LAS u32x2*)(vp + 16); vw.z = vb.x; vw.w = vb.y; } else { vw.z = 0u; vw.w = 0u; }
                o[dt] = MFMA16(pa, as_bf16x8(vw), o[dt]);
            }
        }
#pragma unroll
        for (int dt = 0; dt < 4; ++dt)
#pragma unroll
            for (int jj = 0; jj < 4; ++jj)
                YA[(size_t)(n * 128 + i0 + g4 * 4 + jj) * 1024 + hq * 64 + dt * 16 + l15] = f2bf(o[dt][jj]);
    }
    __syncthreads();
}

#undef SWA_QLOAD
__device__ __forceinline__ void gla_bcum(const bf16_t* P, const float* wgate, const float* bgate, int n, int h, LAS float* bc, LAS float* glr_s, LAS float* wg_s) {
    const int tid = otid();
    if (tid < 128) { const int t = tid >> 1, r0 = (tid & 1) * 8;
        const u32x4 w = *(const u32x4*)(P + (size_t)(n * 64 + t) * NP + C_GLR + r0); float f[8]; unpack8(w, f);
#pragma unroll
        for (int i = 0; i < 8; ++i) glr_s[t * 16 + r0 + i] = f[i]; }
    { const int r = tid >> 5, d0 = (tid & 31) * 4; const f32x4 w = *(const f32x4*)(wgate + r * 512 + h * 128 + d0);
      *(LAS f32x4*)(wg_s + r * 128 + d0) = w; }
    __syncthreads();
    const int d = tid & 127, tq = tid >> 7;
    float wreg[16];
#pragma unroll
    for (int r = 0; r < 16; ++r) wreg[r] = wg_s[r * 128 + d];
    const float bias = bgate[h * 128 + d];
    float c = 0.f;
    for (int tt = 0; tt < 16; ++tt) { const int t = tq * 16 + tt;
        float z = bias;
#pragma unroll
        for (int r = 0; r < 16; r += 4) { const f32x4 gv = *(const LAS f32x4*)(glr_s + t * 16 + r); z += gv[0] * wreg[r] + gv[1] * wreg[r + 1] + gv[2] * wreg[r + 2] + gv[3] * wreg[r + 3]; }
        const float ls = fminf(z, 0.f) - __logf(1.0f + __expf(-fabsf(z)));
        c += ls * (1.0f / 16.0f);
        bc[t * 128 + d] = c; }
    __syncthreads();
    float off = 0.f;
    for (int q = 0; q < tq; ++q) off += bc[(q * 16 + 15) * 128 + d];
    __syncthreads();
    if (tq > 0) { for (int tt = 0; tt < 16; ++tt) bc[(tq * 16 + tt) * 128 + d] += off; }
    __syncthreads();
}
__device__ __forceinline__ void gla_stage_vt(const bf16_t* P, int n, int h, LAS bf16_t* Vt) {
    const int tid = otid(), t = tid >> 3, e0 = (tid & 7) * 32;
    const bf16_t* vp = P + (size_t)(n * 64 + t) * NP + C_GV + h * 256 + e0;
#pragma unroll
    for (int q = 0; q < 4; ++q) { const u32x4 w = *(const u32x4*)(vp + q * 8); const int e = e0 + q * 8;
        Vt[(e + 0) * 72 + t] = (bf16_t)(w.x & 0xffffu); Vt[(e + 1) * 72 + t] = (bf16_t)(w.x >> 16);
        Vt[(e + 2) * 72 + t] = (bf16_t)(w.y & 0xffffu); Vt[(e + 3) * 72 + t] = (bf16_t)(w.y >> 16);
        Vt[(e + 4) * 72 + t] = (bf16_t)(w.z & 0xffffu); Vt[(e + 5) * 72 + t] = (bf16_t)(w.z >> 16);
        Vt[(e + 6) * 72 + t] = (bf16_t)(w.w & 0xffffu); Vt[(e + 7) * 72 + t] = (bf16_t)(w.w >> 16); }
}

__device__ __forceinline__ void gla_store_vt(const u32x4 (&rv)[4], int t, int e0, LAS bf16_t* Vt) {
#pragma unroll
    for (int q = 0; q < 4; ++q) { const u32x4 w = rv[q]; const int e = e0 + q * 8;
        Vt[(e + 0) * 72 + t] = (bf16_t)(w.x & 0xffffu); Vt[(e + 1) * 72 + t] = (bf16_t)(w.x >> 16);
        Vt[(e + 2) * 72 + t] = (bf16_t)(w.y & 0xffffu); Vt[(e + 3) * 72 + t] = (bf16_t)(w.y >> 16);
        Vt[(e + 4) * 72 + t] = (bf16_t)(w.z & 0xffffu); Vt[(e + 5) * 72 + t] = (bf16_t)(w.z >> 16);
        Vt[(e + 6) * 72 + t] = (bf16_t)(w.w & 0xffffu); Vt[(e + 7) * 72 + t] = (bf16_t)(w.w >> 16); }
}

__device__ __forceinline__ void gla_pass1_item(const Params& p, int l, int n, int h, LAS unsigned char* lds) {
    const int tid = otid(), lane = tid & 63, wid = tid >> 6, l15 = lane & 15, g4 = lane >> 4;
    const bf16_t* P = (const bf16_t*)(p.ws + WS_P);
    LAS float* bc = (LAS float*)lds;
    LAS bf16_t* KdT = (LAS bf16_t*)(lds + 32768);
    LAS bf16_t* Vt = (LAS bf16_t*)(lds + 51200);
    LAS float* glr_s = (LAS float*)(lds + 88064);
    LAS float* wg_s = (LAS float*)(lds + 92160);
    const int st = tid >> 3, sd0 = (tid & 7) * 16, se0 = (tid & 7) * 32;
    const bf16_t* rowp = P + (size_t)(n * 64 + st) * NP;
    u32x4 rk[2], rv[4];
#pragma unroll
    for (int q = 0; q < 2; ++q) rk[q] = *(const u32x4*)(rowp + C_GK + h * 128 + sd0 + q * 8);
#pragma unroll
    for (int q = 0; q < 4; ++q) rv[q] = *(const u32x4*)(rowp + C_GV + h * 256 + se0 + q * 8);
    gla_bcum(P, kin(14) + (size_t)l * 16 * 512, kin(15) + (size_t)l * 512, n, h, bc, glr_s, wg_s);
    if (tid < 128) ((float*)(p.ws + WS_GDEC))[(size_t)(n * 4 + h) * 128 + tid] = __expf(bc[63 * 128 + tid]);
#pragma unroll
    for (int q = 0; q < 2; ++q) { float f[8]; unpack8(rk[q], f);
#pragma unroll
        for (int i = 0; i < 8; ++i) { const int d = sd0 + q * 8 + i; KdT[d * 72 + st] = f2bf(f[i] * __expf(bc[63 * 128 + d] - bc[st * 128 + d])); } }
    gla_store_vt(rv, st, se0, Vt);
    __syncthreads();
    bf16_t* GS = (bf16_t*)(p.ws + WS_GS) + (size_t)(n * 4 + h) * 256 * 128;
#pragma unroll
    for (int ei = 0; ei < 2; ++ei) { const int et = wid * 2 + ei;
        bf16x8 vf[2];
#pragma unroll
        for (int ks = 0; ks < 2; ++ks) vf[ks] = *(const LAS bf16x8*)(Vt + (et * 16 + l15) * 72 + ks * 32 + g4 * 8);
#pragma unroll
        for (int dt = 0; dt < 8; ++dt) {
            f32x4 a = (f32x4){0.f, 0.f, 0.f, 0.f};
#pragma unroll
            for (int ks = 0; ks < 2; ++ks) { const bf16x8 kf = *(const LAS bf16x8*)(KdT + (dt * 16 + l15) * 72 + ks * 32 + g4 * 8);
                a = MFMA16(kf, vf[ks], a); }
            u32x2 w; w.x = cvt_pk_bf16(a[0], a[1]); w.y = cvt_pk_bf16(a[2], a[3]);
            *(u32x2*)(GS + (size_t)(et * 16 + l15) * 128 + dt * 16 + g4 * 4) = w;
        } }
    __syncthreads();
}

__device__ __forceinline__ void gla_pass3_item(const Params& p, int l, int n, int h, LAS unsigned char* lds) {
    const int tid = otid(), lane = tid & 63, wid = tid >> 6, l15 = lane & 15, g4 = lane >> 4;
    const bf16_t* P = (const bf16_t*)(p.ws + WS_P);
    LAS float* bc = (LAS float*)lds;
    LAS bf16_t* Gs = (LAS bf16_t*)lds;
    LAS bf16_t* Qs = (LAS bf16_t*)(lds + 32768);
    LAS bf16_t* Kn = (LAS bf16_t*)(lds + 50176);
    LAS bf16_t* Vt = (LAS bf16_t*)(lds + 67584);
    LAS bf16_t* At = (LAS bf16_t*)(lds + 104448);
    LAS float* glr_s = (LAS float*)(lds + 113664);
    LAS float* wg_s = (LAS float*)(lds + 117760);
    LAS float* ssq = (LAS float*)(lds + 125952);
    const int st = tid >> 3, sd0 = (tid & 7) * 16, se0 = (tid & 7) * 32;
    const bf16_t* rowp = P + (size_t)(n * 64 + st) * NP;
    u32x4 rq[2], rk[2], rv[4], rg[4];
#pragma unroll
    for (int q = 0; q < 2; ++q) { rq[q] = *(const u32x4*)(rowp + C_GQ + h * 128 + sd0 + q * 8); rk[q] = *(const u32x4*)(rowp + C_GK + h * 128 + sd0 + q * 8); }
#pragma unroll
    for (int q = 0; q < 4; ++q) { rv[q] = *(const u32x4*)(rowp + C_GV + h * 256 + se0 + q * 8); rg[q] = *(const u32x4*)(rowp + C_GOUT + h * 256 + se0 + q * 8); }
    gla_bcum(P, kin(14) + (size_t)l * 16 * 512, kin(15) + (size_t)l * 512, n, h, bc, glr_s, wg_s);
#pragma unroll
    for (int q = 0; q < 2; ++q) { float fq_[8], fk[8]; unpack8(rq[q], fq_); unpack8(rk[q], fk);
#pragma unroll
        for (int i = 0; i < 8; ++i) { const float b = bc[st * 128 + sd0 + q * 8 + i]; fq_[i] = fq_[i] * 0.08838834764831845f * __expf(b); fk[i] = fk[i] * __expf(-b); }
        *(LAS u32x4*)(Qs + st * 136 + sd0 + q * 8) = pack8(fq_); *(LAS u32x4*)(Kn + st * 136 + sd0 + q * 8) = pack8(fk); }
    gla_store_vt(rv, st, se0, Vt);
    __syncthreads();
    const bf16_t* GS = (const bf16_t*)(p.ws + WS_GST) + (size_t)(n * 4 + h) * 256 * 128;
    bf16x8 sf[2][4];
#pragma unroll
    for (int ei = 0; ei < 2; ++ei)
#pragma unroll
        for (int ks = 0; ks < 4; ++ks) sf[ei][ks] = *(const bf16x8*)(GS + (size_t)((wid * 2 + ei) * 16 + l15) * 128 + ks * 32 + g4 * 8);
    const float* ng = kin(16) + (size_t)l * 1024 + h * 256;
    float ngv[2];
#pragma unroll
    for (int ei = 0; ei < 2; ++ei) ngv[ei] = ng[(wid * 2 + ei) * 16 + l15];
#pragma unroll
    for (int q = 0; q < 4; ++q) *(LAS u32x4*)(Gs + st * 256 + se0 + q * 8) = rg[q];
#pragma unroll
    for (int ii = 0; ii < 2; ++ii) { const int id = wid * 2 + ii, ti = id >> 2, tj = id & 3;
        f32x4 a = (f32x4){0.f, 0.f, 0.f, 0.f};
        if (tj <= ti) {
#pragma unroll
            for (int ks = 0; ks < 4; ++ks) { const bf16x8 qf = *(const LAS bf16x8*)(Qs + (ti * 16 + l15) * 136 + ks * 32 + g4 * 8);
                const bf16x8 kf = *(const LAS bf16x8*)(Kn + (tj * 16 + l15) * 136 + ks * 32 + g4 * 8);
                a = MFMA16(qf, kf, a); }
            if (tj == ti) {
#pragma unroll
                for (int jj = 0; jj < 4; ++jj) if (g4 * 4 + jj < l15) a[jj] = 0.f; }
        }
#pragma unroll
        for (int jj = 0; jj < 4; ++jj) At[(ti * 16 + g4 * 4 + jj) * 72 + tj * 16 + l15] = f2bf(a[jj]); }
    __syncthreads();
    f32x4 o[2][4];
#pragma unroll
    for (int ei = 0; ei < 2; ++ei) { const int et = wid * 2 + ei;
        bf16x8 vf[2];
#pragma unroll
        for (int ks = 0; ks < 2; ++ks) vf[ks] = *(const LAS bf16x8*)(Vt + (et * 16 + l15) * 72 + ks * 32 + g4 * 8);
#pragma unroll
        for (int ti = 0; ti < 4; ++ti) {
            f32x4 a = (f32x4){0.f, 0.f, 0.f, 0.f};
#pragma unroll
            for (int ks = 0; ks < 4; ++ks) { const bf16x8 qf = *(const LAS bf16x8*)(Qs + (ti * 16 + l15) * 136 + ks * 32 + g4 * 8); a = MFMA16(qf, sf[ei][ks], a); }
#pragma unroll
            for (int ks = 0; ks < 2; ++ks) if (ks * 32 <= ti * 16 + 15) { const bf16x8 af = *(const LAS bf16x8*)(At + (ti * 16 + l15) * 72 + ks * 32 + g4 * 8); a = MFMA16(af, vf[ks], a); }
            o[ei][ti] = a;
        } }
#pragma unroll
    for (int ti = 0; ti < 4; ++ti)
#pragma unroll
        for (int jj = 0; jj < 4; ++jj) { float s = o[0][ti][jj] * o[0][ti][jj] + o[1][ti][jj] * o[1][ti][jj];
            s += __shfl_xor(s, 1); s += __shfl_xor(s, 2); s += __shfl_xor(s, 4); s += __shfl_xor(s, 8);
            if (l15 == 0) ssq[wid * 64 + ti * 16 + g4 * 4 + jj] = s; }
    __syncthreads();
    bf16_t* YG = (bf16_t*)(p.ws + WS_YG);
#pragma unroll
    for (int ti = 0; ti < 4; ++ti)
#pragma unroll
        for (int jj = 0; jj < 4; ++jj) { const int t = ti * 16 + g4 * 4 + jj;
            float tot = 0.f;
#pragma unroll
            for (int w = 0; w < 8; ++w) tot += ssq[w * 64 + t];
            const float rs = __builtin_amdgcn_rsqf(tot * (1.0f / 256.0f) + EPS);
#pragma unroll
            for (int ei = 0; ei < 2; ++ei) { const int e = (wid * 2 + ei) * 16 + l15;
                const float gt = bf2f(Gs[t * 256 + e]);
                const float v = o[ei][ti][jj] * rs * ngv[ei] * (gt * sigmoidf_(gt));
                YG[(size_t)(n * 64 + t) * 1024 + h * 256 + e] = f2bf(v); } }
    __syncthreads();
}

template <bool FINAL>
__device__ __forceinline__ void s5_pass(const Params& p, int l, LAS unsigned char* lds) {
    const int tid = otid(), lane = tid & 63, wid = tid >> 6, l15 = lane & 15, g4 = lane >> 4;
    bf16_t* P = (bf16_t*)(p.ws + WS_P);
    LAS float* X = (LAS float*)(lds + wid * 12800);
    LAS bf16_t* H = (LAS bf16_t*)(lds + wid * 12800 + 8448);
    const int bid_ = obid();
    const int g = (bid_ & 15) * 4 + (wid & 3), nb = (bid_ >> 4) * 2 + (wid >> 2);
    const bf16_t* bb = (const bf16_t*)(p.ws + WS_BB) + (size_t)g * 128 * 16;
    bf16x8 bf[8];
#pragma unroll
    for (int pt = 0; pt < 8; ++pt) { u32x4 w = (u32x4){0u, 0u, 0u, 0u}; if (g4 < 2) w = *(const u32x4*)(bb + (pt * 16 + l15) * 16 + g4 * 8); bf[pt] = as_bf16x8(w); }
    const f32x2 A = ((const f32x2*)(p.ws + WS_SA))[g * 64 + lane];
    bf16x8 cf[4], idB; float dsk = 0.f;
    if (FINAL) { const bf16_t* cc = (const bf16_t*)(p.ws + WS_CC) + (size_t)g * 16 * 128;
#pragma unroll
        for (int ks = 0; ks < 4; ++ks) cf[ks] = *(const bf16x8*)(cc + l15 * 128 + ks * 32 + g4 * 8);
        dsk = kin(10)[(size_t)l * 1024 + g * 16 + l15];
        unsigned e[8];
#pragma unroll
        for (int j = 0; j < 8; ++j) e[j] = (g4 * 8 + j == l15) ? 0x3F80u : 0u;
        u32x4 w; w.x = e[0] | (e[1] << 16); w.y = e[2] | (e[3] << 16); w.z = e[4] | (e[5] << 16); w.w = e[6] | (e[7] << 16);
        idB = as_bf16x8(w); }
    f32x2* S5C = (f32x2*)(p.ws + WS_S5C);
    const f32x2* S5S = (const f32x2*)(p.ws + WS_S5S);
    const bf16_t* ubase = P + (size_t)l15 * NP + C_U + g * 16 + g4 * 8;
#define S5_TROW(q) ((size_t)(nb + 32 * ((q) >> 2)) * 64 + (size_t)(((q) & 3) * 16))
    u32x4 unext = (u32x4){0u, 0u, 0u, 0u};
    if (g4 < 2) unext = *(const u32x4*)(ubase + S5_TROW(0) * NP);
    f32x2 s0next = (f32x2){0.f, 0.f};
    if (FINAL) s0next = S5S[((size_t)nb * 64 + g) * 64 + lane];
    float sr = 0.f, si = 0.f;
    for (int q = 0; q < 32; ++q) {
        const size_t trow = S5_TROW(q);
        const int n = nb + 32 * (q >> 2);
        const bf16x8 ua = as_bf16x8(unext);
        if (q + 1 < 32) { u32x4 t = (u32x4){0u, 0u, 0u, 0u}; if (g4 < 2) t = *(const u32x4*)(ubase + S5_TROW(q + 1) * NP); unext = t; }
        if ((q & 3) == 0) { sr = FINAL ? s0next.x : 0.f; si = FINAL ? s0next.y : 0.f;
            if (FINAL && q + 4 < 32) s0next = S5S[((size_t)(n + 32) * 64 + g) * 64 + lane]; }
#pragma unroll
        for (int pt = 0; pt < 8; ++pt) { f32x4 d = (f32x4){0.f, 0.f, 0.f, 0.f}; d = MFMA16(ua, bf[pt], d);
#pragma unroll
            for (int jj = 0; jj < 4; ++jj) X[(g4 * 4 + jj) * 132 + pt * 16 + l15] = d[jj]; }
        f32x4 uD = (f32x4){0.f, 0.f, 0.f, 0.f};
        if (FINAL) uD = MFMA16(ua, idB, uD);
        LDS_FENCE();
#pragma unroll
        for (int t = 0; t < 16; ++t) { const float xr = X[t * 132 + lane], xi = X[t * 132 + 64 + lane];
            cplx_step(A, sr, si, xr, xi);
            if (FINAL) { H[t * 136 + lane] = f2bf(sr); H[t * 136 + 64 + lane] = f2bf(si); } }
        LDS_FENCE();
        if (FINAL) {
            f32x4 y = (f32x4){0.f, 0.f, 0.f, 0.f};
#pragma unroll
            for (int ks = 0; ks < 4; ++ks) { const bf16x8 hf = *(const LAS bf16x8*)(H + l15 * 136 + ks * 32 + g4 * 8); y = MFMA16(hf, cf[ks], y); }
#pragma unroll
            for (int jj = 0; jj < 4; ++jj) {
                const float yv = y[jj] + dsk * uD[jj];
                const float inner = 0.7978845608028654f * (yv + 0.044715f * yv * yv * yv);
                const float z = yv * sigmoidf_(2.0f * inner);
                P[(trow + g4 * 4 + jj) * NP + C_AQ + g * 16 + l15] = f2bf(z); }
            LDS_FENCE();
        }
        if (!FINAL && (q & 3) == 3) S5C[((size_t)n * 64 + g) * 64 + lane] = (f32x2){sr, si};
    }
#undef S5_TROW
}

__device__ __forceinline__ void phase_scan(const Params& p) {
    const int tid = otid(), lane = tid & 63, wid = tid >> 6;
    const int gw = wid * gridDim.x + obid();
    if (gw < 1024) {
        const int idx = gw * 64 + lane, h = idx >> 14, e = (idx >> 6) & 255, dp = idx & 63;
        const unsigned* gs = (const unsigned*)(p.ws + WS_GS) + ((size_t)(h * 256 + e) * 128 + dp * 2) / 2;
        unsigned* gst = (unsigned*)(p.ws + WS_GST) + ((size_t)(h * 256 + e) * 128 + dp * 2) / 2;
        const f32x2* dec = (const f32x2*)(p.ws + WS_GDEC) + ((size_t)h * 128 + dp * 2) / 2;
        float s0 = 0.f, s1 = 0.f;
        unsigned un[16]; f32x2 dn[16];
#pragma unroll
        for (int j = 0; j < 16; ++j) { un[j] = gs[(size_t)j * (4 * 256 * 128 / 2)]; dn[j] = dec[(size_t)j * (4 * 128 / 2)]; }
        for (int n0 = 0; n0 < 256; n0 += 16) {
            unsigned u[16]; f32x2 dc[16];
#pragma unroll
            for (int j = 0; j < 16; ++j) { u[j] = un[j]; dc[j] = dn[j]; }
            if (n0 + 16 < 256) {
#pragma unroll
                for (int j = 0; j < 16; ++j) { un[j] = gs[(size_t)(n0 + 16 + j) * (4 * 256 * 128 / 2)]; dn[j] = dec[(size_t)(n0 + 16 + j) * (4 * 128 / 2)]; } }
#pragma unroll
            for (int j = 0; j < 16; ++j) { gst[(size_t)(n0 + j) * (4 * 256 * 128 / 2)] = cvt_pk_bf16(s0, s1);
                s0 = dc[j].x * s0 + bflo(u[j]); s1 = dc[j].y * s1 + bfhi(u[j]); }
        }
    } else if (gw < 1088) {
        const int g = gw - 1024;
        const f32x2 A = ((const f32x2*)(p.ws + WS_SA64))[g * 64 + lane];
        const f32x2* sc = (const f32x2*)(p.ws + WS_S5C) + (size_t)g * 64 + lane;
        f32x2* ss = (f32x2*)(p.ws + WS_S5S) + (size_t)g * 64 + lane;
        float sr = 0.f, si = 0.f;
        for (int n0 = 0; n0 < 256; n0 += 32) {
            f32x2 e[32];
#pragma unroll
            for (int j = 0; j < 32; ++j) e[j] = sc[(size_t)(n0 + j) * 4096];
#pragma unroll
            for (int j = 0; j < 32; ++j) { ss[(size_t)(n0 + j) * 4096] = (f32x2){sr, si};
                cplx_step(A, sr, si, e[j].x, e[j].y); }
        }
    }
}

constexpr int N_PHASES = 20;
__device__ __forceinline__ void run_phase(const Params& p, LAS unsigned char* lds, const int ph) {
    unsigned char* ws = p.ws;
    bf16_t* P = (bf16_t*)(ws + WS_P);
    bf16_t* HB = (bf16_t*)(ws + WS_HB);
    bf16_t* XB2 = (bf16_t*)(ws + WS_YA);
    float* RSS = (float*)(ws + WS_RSS);
    if (ph == 19) { phase_norm<false>(p.out, kin(24), nullptr, p.out); return; }
    const int l = (ph >= 10) ? 1 : 0, s = (ph >= 10) ? ph - 10 : ph;
    const int step = (l == 0) ? s : s + 1;
    const float* xin = (l == 0) ? kin(0) : p.out;
    switch (step) {
    case 0: {
        phase_conv<false>(p, 0, lds);
        phase_xb(kin(0), HB, RSS);
    } break;
    case 1: {
        pg8::Gemm g{HB, (const bf16_t*)(ws + WS_WIN), SEQ, NP, DM, DM};
        pg8::EpiProj E{P, RSS + (size_t)(l == 0 ? 0 : 2) * SEQ};
        pg8::gemm_phase(lds, g, E);
    } break;
    case 2: {
        for (int it = obid(); it < 512; it += gridDim.x) swa_item(P, (bf16_t*)(ws + WS_YA), (const float*)(ws + WS_ROPE), kin(13) + l * 16, it >> 2, it & 3, lds);
        for (int it = obid(); it < 1024; it += gridDim.x) gla_pass1_item(p, l, it >> 2, it & 3, lds);
        s5_pass<false>(p, l, lds);
    } break;
    case 3: phase_scan(p); break;
    case 4: {
        for (int it = obid(); it < 1024; it += gridDim.x) gla_pass3_item(p, l, it >> 2, it & 3, lds);
        s5_pass<true>(p, l, lds);
    } break;
    case 5: {
        __syncthreads();
        phase_conv<true>(p, l, lds);
        __syncthreads();
        pg8::Gemm g{P + C_AQ, (const bf16_t*)(ws + WS_WGLU), SEQ, 1024, 1024, NP};
        pg8::EpiGlu E{P, kin(12) + (size_t)l * 1024};
        pg8::gemm_phase(lds, g, E);
    } break;
    case 6: {
        for (int br = 0; br < 3; ++br) {
            const bf16_t* A = (br == 0) ? P + C_GQ : (const bf16_t*)(ws + (br == 1 ? WS_YA : WS_YG));
            const bf16_t* W = (const bf16_t*)(ws + (br == 0 ? WS_WBS : (br == 1 ? WS_WBA : WS_WBG)));
            pg8::Gemm g{A, W, SEQ, DM, 1024, (br == 0) ? NP : 1024};
            pg8::EpiBranch E{P, HB, br};
            pg8::gemm_phase(lds, g, E);
        }
    } break;
    case 7: {
        pg8::Gemm g{HB, (const bf16_t*)(ws + WS_WOUT), SEQ, DM, DM, DM};
        pg8::EpiResid E{xin, p.out, XB2, RSS + (size_t)(l == 0 ? 1 : 3) * SEQ};
        pg8::gemm_phase(lds, g, E);
    } break;
    case 8: {
        if (l == 0) { __syncthreads(); phase_conv<false>(p, 1, lds); __syncthreads(); }
        pg8::Gemm g{XB2, (const bf16_t*)(ws + WS_WFF1), SEQ, DFF, DM, DM};
        pg8::EpiRelu2 E{P, RSS + (size_t)(l == 0 ? 1 : 3) * SEQ};
        pg8::gemm_phase(lds, g, E);
#ifdef PROBE_FFN1
        if (l == 1) pg8::gemm_phase(lds, g, E);
#endif
    } break;
    default: {
        pg8::Gemm g{P, (const bf16_t*)(ws + WS_WFF2), SEQ, DM, DFF, DFF};
        pg8::EpiResid E{p.out, p.out, (l == 0) ? HB : nullptr, (l == 0) ? RSS + (size_t)2 * SEQ : nullptr};
        pg8::gemm_phase(lds, g, E);
    } break;
    }
}


#define XB_XCNT(j)  (256  + 64 * (j))
#define XB_XSUB(j)  (1280 + 64 * (j))
#define XB_XGEN(j)  (2304 + 64 * (j))
#define XB_TOP      3328
#define XB_TOPGEN   3392
__device__ __forceinline__ unsigned xb_ld(unsigned* p)              { return __hip_atomic_load(p, __ATOMIC_RELAXED, __HIP_MEMORY_SCOPE_AGENT); }
__device__ __forceinline__ unsigned xb_add(unsigned* p, unsigned v) { return __hip_atomic_fetch_add(p, v, __ATOMIC_RELAXED, __HIP_MEMORY_SCOPE_AGENT); }
__device__ __forceinline__ unsigned xb_xcc_id() { return (unsigned)__builtin_amdgcn_s_getreg((3 << 11) | 20) & 0xFu; }
__device__ __forceinline__ void grid_barrier(unsigned* bar, const unsigned xcc, unsigned& nloc, unsigned& nx) {
    asm volatile("s_waitcnt vmcnt(0)" ::: "memory");
    __syncthreads();
    if (otid() == 0) {
        if (nloc == 0u) {
            const unsigned G = gridDim.x;
            for (;;) { unsigned sum = 0u, cnt = 0u, mine = 0u;
#pragma unroll
                for (unsigned j = 0; j < 16; ++j) { const unsigned c = xb_ld(&bar[XB_XCNT(j)]); sum += c; cnt += (c > 0u) ? 1u : 0u; mine = (j == xcc) ? c : mine; }
                if (sum == G) { nloc = mine; nx = cnt; break; }
                __builtin_amdgcn_s_sleep(1); } }
        const unsigned old = xb_add(&bar[XB_XSUB(xcc)], 1u);
        const unsigned gen = old / nloc;
        if (old + 1u == (gen + 1u) * nloc) {
            __builtin_amdgcn_fence(__ATOMIC_RELEASE, "agent");
            asm volatile("s_waitcnt vmcnt(0)" ::: "memory");
            const unsigned og = xb_add(&bar[XB_TOP], 1u);
            const unsigned tg = og / nx;
            if (og + 1u == (tg + 1u) * nx) xb_add(&bar[XB_TOPGEN], 1u);
            else while (xb_ld(&bar[XB_TOPGEN]) == tg) __builtin_amdgcn_s_sleep(1);
            __builtin_amdgcn_fence(__ATOMIC_ACQUIRE, "agent");
            xb_add(&bar[XB_XGEN(xcc)], 1u);
            asm volatile("s_waitcnt vmcnt(0)" ::: "memory");
        } else {
            while (xb_ld(&bar[XB_XGEN(xcc)]) == gen) __builtin_amdgcn_s_sleep(1);
            __builtin_amdgcn_fence(__ATOMIC_ACQUIRE, "agent");
            asm volatile("s_waitcnt vmcnt(0)" ::: "memory");
        }
    }
    __syncthreads();
}
#define MK_PHASE(k) if (p.ph_lo <= (k) && (k) < p.ph_hi) { if ((k) > p.ph_lo) { grid_barrier(xbar, xcc, xb_nloc, xb_nx); } run_phase(p, lds, (k)); }
__global__ void __launch_bounds__(512, 2) mega(Params p) {
    extern __shared__ __attribute__((aligned(16))) unsigned char shm_[];
    LAS unsigned char* lds = (LAS unsigned char*)shm_;
    unsigned* xbar = (unsigned*)(p.ws + WS_END);
    const unsigned xcc = xb_xcc_id();
    unsigned xb_nloc = 0u, xb_nx = 0u;
    if (p.ph_hi - p.ph_lo > 1 && otid() == 0) (void)xb_add(&xbar[XB_XCNT(xcc)], 1u);
    if (p.ph_lo < 0) cg::this_grid().sync();
    MK_PHASE(0) MK_PHASE(1) MK_PHASE(2) MK_PHASE(3) MK_PHASE(4) MK_PHASE(5) MK_PHASE(6) MK_PHASE(7) MK_PHASE(8) MK_PHASE(9) MK_PHASE(10)
    MK_PHASE(11) MK_PHASE(12) MK_PHASE(13) MK_PHASE(14) MK_PHASE(15) MK_PHASE(16) MK_PHASE(17) MK_PHASE(18) MK_PHASE(19)
    if (DBG_STOP >= 0 && !MK_LAUNCH_PER_PHASE) {
        cg::this_grid().sync();
        __builtin_amdgcn_fence(__ATOMIC_ACQUIRE, "agent");
        const unsigned* w = (const unsigned*)p.ws; const size_t nwords = WS_END / 4, nout = (size_t)SEQ * DM;
        for (size_t i = (size_t)obid() * 512 + otid(); i < nout; i += (size_t)gridDim.x * 512) {
            float s = 0.f;
            for (size_t j = i; j < nwords; j += nout) { const unsigned v = w[j]; s += (float)((v >> 16) ^ (v & 0xffffu)); }
            p.out[i] = s * (1.0f / 65536.0f);
        }
    }
}


__global__ void dbg_digest(const unsigned* w, float* out, size_t nwords, size_t nout) {
    for (size_t i = (size_t)blockIdx.x * blockDim.x + threadIdx.x; i < nout; i += (size_t)gridDim.x * blockDim.x) {
        float s = 0.f;
        for (size_t j = i; j < nwords; j += nout) { const unsigned v = w[j]; s += (float)((v >> 16) ^ (v & 0xffffu)); }
        out[i] = s * (1.0f / 65536.0f);
    }
}
extern "C" void kernel_launch(void* const* d_in, const int* in_sizes, int n_in, void* d_out, int out_size, void* d_ws, size_t ws_size, hipStream_t stream) {
    static int ready = 0;
    if (!ready) {
        if (n_in != 25 || out_size != SEQ * DM || ws_size < WS_TOTAL) { fprintf(stderr, "kernel_launch: unexpected shapes (n_in %d out %d ws %zu need %zu)\n", n_in, out_size, ws_size, (size_t)WS_END); ready = -1; return; }
        if (hipFuncSetAttribute((const void*)mega, hipFuncAttributeMaxDynamicSharedMemorySize, LDS_BYTES) != hipSuccess) { fprintf(stderr, "kernel_launch: hipFuncSetAttribute failed\n"); ready = -1; return; }
        ready = 1;
    }
    if (ready < 0) return;
    Params p{};
    for (int i = 0; i < 25; ++i) p.in[i] = (const float*)d_in[i];
    p.out = (float*)d_out; p.ws = (unsigned char*)d_ws;
#if MK_LAUNCH_PER_PHASE
    for (int ph = 0; ph < (DBG_STOP >= 0 ? DBG_STOP + 1 : N_PHASES); ++ph) {
        p.ph_lo = ph; p.ph_hi = ph + 1;
        hipLaunchKernelGGL(mega, dim3(256), dim3(512), LDS_BYTES, stream, p);
    }
    if (DBG_STOP >= 0) hipLaunchKernelGGL(dbg_digest, dim3(2048), dim3(256), 0, stream, (const unsigned*)d_ws, (float*)d_out, (size_t)(WS_END / 4), (size_t)SEQ * DM);
#else
    p.ph_lo = 0; p.ph_hi = (DBG_STOP >= 0) ? DBG_STOP + 1 : N_PHASES;
    hipMemsetAsync((unsigned char*)d_ws + WS_END, 0, WS_TOTAL - WS_END, stream);
    void* args[] = {&p};
    hipError_t e = hipLaunchCooperativeKernel((const void*)mega, dim3(256), dim3(512), args, LDS_BYTES, stream);
    if (e != hipSuccess) fprintf(stderr, "cooperative launch failed: %s\n", hipGetErrorString(e));
#endif
}
```

```cpp
#include <hip/hip_runtime.h>
#include <hip/hip_cooperative_groups.h>
#include <cstdio>
namespace cg = cooperative_groups;

#ifndef DBG_STOP
#define DBG_STOP -1
#endif
#ifndef MK_LAUNCH_PER_PHASE
#define MK_LAUNCH_PER_PHASE 0
#endif

#ifndef P2MASK
#define P2MASK 7
#endif
#ifndef PHMASK
#define PHMASK 0xfff
#endif
#define PH_ON(k) ((PHMASK >> (k)) & 1)
#define LAS __attribute__((address_space(3)))
typedef unsigned short bf16_t;
typedef short bf16x8 __attribute__((ext_vector_type(8)));
typedef float f32x4 __attribute__((ext_vector_type(4)));
typedef float f32x2 __attribute__((ext_vector_type(2)));
typedef unsigned u32x4 __attribute__((ext_vector_type(4)));
typedef unsigned u32x2 __attribute__((ext_vector_type(2)));

constexpr int SEQ = 16384, DM = 2048, DFF = 8192, NP = 12032;
constexpr int C_U = 0, C_AQ = 1024, C_AK = 2048, C_AV = 2304, C_GQ = 2560, C_GK = 3072, C_GV = 3584, C_GOUT = 4608, C_MERGE = 5632, C_GLR = 11776;
constexpr int IN_W = 11792;
constexpr float EPS = 1e-6f;

constexpr size_t WS_WIN = 0;
constexpr size_t WS_WGLU = WS_WIN + (size_t)NP * DM * 2;
constexpr size_t WS_WBS = WS_WGLU + (size_t)1024 * 1024 * 2;
constexpr size_t WS_WBA = WS_WBS + (size_t)2048 * 1024 * 2;
constexpr size_t WS_WBG = WS_WBA + (size_t)2048 * 1024 * 2;
constexpr size_t WS_WOUT = WS_WBG + (size_t)2048 * 1024 * 2;
constexpr size_t WS_WFF1 = WS_WOUT + (size_t)2048 * 2048 * 2;
constexpr size_t WS_WFF2 = WS_WFF1 + (size_t)DFF * DM * 2;
constexpr size_t WS_P = WS_WFF2 + (size_t)DFF * DM * 2;
constexpr size_t WS_HB = WS_P + (size_t)SEQ * NP * 2;
constexpr size_t WS_GS = WS_HB + (size_t)SEQ * DM * 2;
constexpr size_t WS_GDEC = WS_GS + (size_t)256 * 4 * 256 * 128 * 2;
constexpr size_t WS_S5C = WS_GDEC + (size_t)256 * 4 * 128 * 4;
constexpr size_t WS_SA = WS_S5C + (size_t)256 * 64 * 64 * 8;
constexpr size_t WS_SA64 = WS_SA + (size_t)64 * 64 * 8;
constexpr size_t WS_BB = WS_SA64 + (size_t)64 * 64 * 8;
constexpr size_t WS_CC = WS_BB + (size_t)64 * 128 * 16 * 2;
constexpr size_t WS_ROPE = WS_CC + (size_t)64 * 16 * 128 * 2;
constexpr size_t WS_YA = WS_ROPE + (size_t)SEQ * 64 * 4;
constexpr size_t WS_YG = WS_YA + (size_t)SEQ * 1024 * 2;
constexpr size_t WS_S5S = WS_YG + (size_t)SEQ * 1024 * 2;
constexpr size_t WS_END = WS_S5S + (size_t)256 * 64 * 64 * 8;
constexpr size_t WS_GST = WS_HB;

constexpr size_t WS_RSS = WS_END + 16384;
constexpr size_t WS_TOTAL = WS_RSS + (size_t)4 * SEQ * 4;
constexpr int LDS_BYTES = 131072;

struct Params { const float* in[25]; float* out; unsigned char* ws; int ph_lo, ph_hi; };

__device__ __forceinline__ int otid() { int t = __builtin_amdgcn_workitem_id_x(); asm volatile("" : "+v"(t)); return t; }
__device__ __forceinline__ int obid() { int b = __builtin_amdgcn_workgroup_id_x(); asm volatile("" : "+s"(b)); return b; }
typedef const float* cfptr;
__device__ __forceinline__ cfptr kin(int k) { asm volatile("" : "+s"(k)); const __attribute__((address_space(4))) cfptr* ka = (const __attribute__((address_space(4))) cfptr*)__builtin_amdgcn_kernarg_segment_ptr(); return ka[k]; }
typedef __bf16 bf16x2v __attribute__((ext_vector_type(2)));
__device__ __forceinline__ unsigned cvt_pk_bf16(float lo, float hi) { f32x2 v = {lo, hi}; bf16x2v r = __builtin_convertvector(v, bf16x2v); return __builtin_bit_cast(unsigned, r); }
__device__ __forceinline__ bf16_t f2bf(float f) { const __bf16 b = (__bf16)f; return __builtin_bit_cast(unsigned short, b); }
__device__ __forceinline__ float bflo(unsigned w) { return __uint_as_float(w << 16); }
__device__ __forceinline__ float bfhi(unsigned w) { return __uint_as_float(w & 0xffff0000u); }
__device__ __forceinline__ float bf2f(bf16_t b) { return __uint_as_float(((unsigned)b) << 16); }
__device__ __forceinline__ float sigmoidf_(float x) { return __builtin_amdgcn_rcpf(1.0f + __expf(-x)); }
__device__ __forceinline__ float wave_sum(float v) {
#pragma unroll
    for (int o = 1; o < 64; o <<= 1) v += __shfl_xor(v, o);
    return v;
}
__device__ __forceinline__ void unpack8(const u32x4 w, float (&f)[8]) {
    f[0] = bflo(w.x); f[1] = bfhi(w.x); f[2] = bflo(w.y); f[3] = bfhi(w.y); f[4] = bflo(w.z); f[5] = bfhi(w.z); f[6] = bflo(w.w); f[7] = bfhi(w.w);
}
__device__ __forceinline__ u32x4 pack8(const float (&f)[8]) {
    u32x4 w; w.x = cvt_pk_bf16(f[0], f[1]); w.y = cvt_pk_bf16(f[2], f[3]); w.z = cvt_pk_bf16(f[4], f[5]); w.w = cvt_pk_bf16(f[6], f[7]); return w;
}
__device__ __forceinline__ bf16x8 as_bf16x8(u32x4 w) { return __builtin_bit_cast(bf16x8, w); }
#ifndef REPMASK
#define REPMASK 0
#endif
#ifndef MFMA_PAD
#define MFMA_PAD 0
#endif
__device__ __forceinline__ f32x4 mfma16_pad(bf16x8 a, bf16x8 b, f32x4 c) {
    f32x4 d = __builtin_amdgcn_mfma_f32_16x16x32_bf16(a, b, c, 0, 0, 0);
#if MFMA_PAD
    asm volatile("s_nop 7\n\ts_nop 7\n\ts_nop 7" : "+v"(d));
#endif
    return d;
}
#define MFMA16(a, b, c) mfma16_pad((a), (b), (c))
#define LDS_FENCE() asm volatile("s_waitcnt lgkmcnt(0)" ::: "memory")

__device__ __forceinline__ void cplx_step(const f32x2 A, float& sr, float& si, const float xr, const float xi) {
    float t1 = __builtin_fmaf(-A.y, si, xr); asm volatile("" : "+v"(t1), "+v"(sr));
    float nr = __builtin_fmaf(A.x, sr, t1);  asm volatile("" : "+v"(nr), "+v"(sr), "+v"(si));
    float t2 = __builtin_fmaf(A.y, sr, xi);  asm volatile("" : "+v"(t2), "+v"(si));
    const float ni = __builtin_fmaf(A.x, si, t2);
    sr = nr; si = ni;
}
__device__ __forceinline__ void sincos_d(double x, double& s, double& c) {
    const double k = rint(x * 0.63661977236758134308);
    double r = fma(-k, 1.57079632679489655800e+00, x);
    r = fma(-k, 6.12323399573676603587e-17, r);
    const double r2 = r * r;
    double sp = 1.0 / 6227020800.0; sp = fma(sp, r2, -1.0 / 39916800.0); sp = fma(sp, r2, 1.0 / 362880.0); sp = fma(sp, r2, -1.0 / 5040.0); sp = fma(sp, r2, 1.0 / 120.0); sp = fma(sp, r2, -1.0 / 6.0);
    const double sr = fma(sp * r2, r, r);
    double cp = 1.0 / 479001600.0; cp = fma(cp, r2, -1.0 / 3628800.0); cp = fma(cp, r2, 1.0 / 40320.0); cp = fma(cp, r2, -1.0 / 720.0); cp = fma(cp, r2, 1.0 / 24.0); cp = fma(cp, r2, -0.5);
    const double cr = fma(cp, r2, 1.0);
    const int q = ((int)k) & 3;
    s = (q == 0) ? sr : (q == 1) ? cr : (q == 2) ? -sr : -cr;
    c = (q == 0) ? cr : (q == 1) ? -sr : (q == 2) ? -cr : sr;
}
__device__ __forceinline__ double exp_d(double x) {
    const double k = rint(x * 1.44269504088896340736);
    const double r = fma(-k, 6.93147180369123816490e-01, x) - k * 1.90821492927058770002e-10;
    double p = 1.0 / 6227020800.0;
    p = fma(p, r, 1.0 / 479001600.0); p = fma(p, r, 1.0 / 39916800.0); p = fma(p, r, 1.0 / 3628800.0); p = fma(p, r, 1.0 / 362880.0); p = fma(p, r, 1.0 / 40320.0);
    p = fma(p, r, 1.0 / 5040.0); p = fma(p, r, 1.0 / 720.0); p = fma(p, r, 1.0 / 120.0); p = fma(p, r, 1.0 / 24.0); p = fma(p, r, 1.0 / 6.0); p = fma(p, r, 0.5); p = fma(p, r, 1.0); p = fma(p, r, 1.0);
    return ldexp(p, (int)k);
}

namespace pg8 {
constexpr int BM = 256, BK = 64, HALF = 128, HTB = HALF * BK * 2, STAGE_BYTES = 8 * HTB, NXCD = 8, WGM = 8;
__device__ __forceinline__ int lds_byte(int r, int c) { const int st = (r >> 4) * 2 + (c >> 5), rr = r & 15, cc = c & 31, ob = rr * 64 + cc * 2; return st * 1024 + (ob ^ (((ob >> 9) & 1) << 5)); }
__device__ __forceinline__ void stage_rc(int b, int& R, int& C) { const int st = b / 1024, sb = b % 1024, swz = sb ^ (((sb >> 9) & 1) << 5); R = (st >> 1) * 16 + swz / 64; C = (st & 1) * 32 + (swz % 64) / 2; }
__device__ __forceinline__ int perm32(int rho) { const int n = rho >> 4, i = rho & 15; return 8 * (i >> 2) + 4 * n + (i & 3); }
struct Unit { int pm, pn; };
struct Gemm { const bf16_t* A; const bf16_t* Bt; int M, N, K, lda; };
struct StaticOrder {
    int nM, nN, nwg, G, c;
    __device__ void init(int M, int N, int G_, int c_) { nM = M / BM; nN = N / BM; nwg = nM * nN; G = G_; c = c_; }
    __device__ bool next(int i, Unit& u) const {
        const long L = (long)i * G + c; if (L >= nwg) return false;
        int wgid = (int)L; { const int q = nwg / NXCD, r = nwg % NXCD, xcd = wgid % NXCD, off = wgid / NXCD; wgid = (xcd < r ? xcd * (q + 1) : r * (q + 1) + (xcd - r) * q) + off; }
        const int nig = WGM * nN, gid = wgid / nig, fm = gid * WGM, gsz = (nM - fm) < WGM ? (nM - fm) : WGM;
        u.pm = fm + ((wgid % nig) % gsz); u.pn = (wgid % nig) / gsz; return true;
    }
};

template <class Epi>
__device__ __forceinline__ void gemm_phase(LAS unsigned char* lds, const Gemm g, const Epi& E) {
    const int tid = otid(), wid = __builtin_amdgcn_readfirstlane(tid >> 6), lane = tid & 63, wr = wid >> 2, wc = wid & 3, fr = lane & 15, fq = lane >> 4;
    const int K = g.K, nt = K / BK, lda = g.lda;
    unsigned voffA[2], voffB[2];
#pragma unroll
    for (int i = 0; i < 2; ++i) { int R, C; stage_rc(tid * 16 + i * 8192, R, C); const int Rb = Epi::PERM ? ((R & ~31) + perm32(R & 31)) : R;
        voffA[i] = (unsigned)(R * lda + C) * 2u; voffB[i] = (unsigned)(Rb * K + C) * 2u; }
    const size_t kstep = (size_t)(BK * 2);
    const size_t hstepA = (size_t)HALF * lda * 2, hstepB = (size_t)HALF * K * 2;
    const size_t tstepA = 2 * hstepA, tstepB = 2 * hstepB;
    const unsigned ldsw = (unsigned)wid * 1024u;
    const int aoff = lds_byte(wr * 64 + fr, fq * 8), boff = lds_byte(wc * 32 + fr, fq * 8);
#define PG8_SA(b, h) (((b) * 2 + (h)) * HTB)
#define PG8_SB(b, h) ((4 + (b) * 2 + (h)) * HTB)
#define PG8_STAGE(bufoff, gbase, voff) do { _Pragma("unroll") for (int _i = 0; _i < 2; ++_i) \
        __builtin_amdgcn_global_load_lds((const unsigned*)((const char*)(gbase) + (voff)[_i]), (LAS unsigned*)(lds + (bufoff) + ldsw + _i * 8192), 16, 0, 0); } while (0)
#define PG8_LDA(dst, b, h) do { _Pragma("unroll") for (int m = 0; m < 4; ++m) _Pragma("unroll") for (int k = 0; k < 2; ++k) dst[m][k] = *(const LAS bf16x8*)(lds + PG8_SA(b, h) + aoff + m * 2048 + k * 1024); } while (0)
#define PG8_LDB(dst, b, h) do { _Pragma("unroll") for (int n = 0; n < 2; ++n) _Pragma("unroll") for (int k = 0; k < 2; ++k) dst[n][k] = *(const LAS bf16x8*)(lds + PG8_SB(b, h) + boff + n * 2048 + k * 1024); } while (0)
#define PG8_MMA(ai, bj, At, Bt) do { __builtin_amdgcn_s_setprio(1); _Pragma("unroll") for (int m = 0; m < 4; ++m) _Pragma("unroll") for (int n = 0; n < 2; ++n) _Pragma("unroll") for (int k = 0; k < 2; ++k) \
        acc[ai][bj][m][n] = __builtin_amdgcn_mfma_f32_16x16x32_bf16(Bt[n][k], At[m][k], acc[ai][bj][m][n], 0, 0, 0); __builtin_amdgcn_s_setprio(0); } while (0)
#define PG8_WAIT_V(n) asm volatile("s_waitcnt vmcnt(" #n ")" ::: "memory")
#define PG8_WAIT_L(n) asm volatile("s_waitcnt lgkmcnt(" #n ")" ::: "memory")
#define PG8_BAR __builtin_amdgcn_s_barrier()
#define PG8_SCHED __builtin_amdgcn_sched_barrier(0)
    StaticOrder S; S.init(g.M, g.N, (int)gridDim.x, (int)obid());
    Unit cur, nxt; int ui = 0;
    if (!S.next(0, cur)) return;
    f32x4 acc[2][2][4][2];
#pragma unroll
    for (int a = 0; a < 2; ++a)
#pragma unroll
        for (int b = 0; b < 2; ++b)
#pragma unroll
            for (int m = 0; m < 4; ++m)
#pragma unroll
                for (int n = 0; n < 2; ++n) acc[a][b][m][n] = (f32x4){0.f, 0.f, 0.f, 0.f};
    bf16x8 At[4][2], B0[2][2], B1[2][2];
    const char* cA = (const char*)g.A + (size_t)cur.pm * tstepA; const char* cB = (const char*)g.Bt + (size_t)cur.pn * tstepB;
    PG8_STAGE(PG8_SB(0, 0), cB, voffB); PG8_STAGE(PG8_SA(0, 0), cA, voffA); PG8_STAGE(PG8_SB(0, 1), cB + hstepB, voffB); PG8_STAGE(PG8_SA(0, 1), cA + hstepA, voffA);
    if (wr == 1) PG8_BAR;
    PG8_WAIT_V(4); PG8_BAR;
    PG8_STAGE(PG8_SB(1, 0), cB + kstep, voffB); PG8_STAGE(PG8_SA(1, 0), cA + kstep, voffA); PG8_STAGE(PG8_SB(1, 1), cB + hstepB + kstep, voffB);
    PG8_WAIT_V(6); PG8_BAR;
    for (;;) {
        const bool has_next = S.next(ui + 1, nxt);
        const char* nA = has_next ? (const char*)g.A + (size_t)nxt.pm * tstepA : cA; const char* nB = has_next ? (const char*)g.Bt + (size_t)nxt.pn * tstepB : cB;
        for (int t = 0; t < nt; t += 2) {
            const bool last = (t == nt - 2);
            const char* a1 = cA + (size_t)(t + 1) * kstep;
            const char* a2 = last ? nA : cA + (size_t)(t + 2) * kstep; const char* b2 = last ? nB : cB + (size_t)(t + 2) * kstep;
            const char* a3 = a2 + kstep; const char* b3 = b2 + kstep;
            PG8_LDB(B0, 0, 0); PG8_SCHED; PG8_LDA(At, 0, 0); PG8_STAGE(PG8_SA(1, 1), a1 + hstepA, voffA);
            PG8_WAIT_L(8); PG8_BAR; PG8_WAIT_L(0); PG8_MMA(0, 0, At, B0); PG8_BAR; PG8_SCHED;
            PG8_LDB(B1, 0, 1); PG8_STAGE(PG8_SB(0, 0), b2, voffB);
            PG8_BAR; PG8_WAIT_L(0); PG8_MMA(0, 1, At, B1); PG8_BAR;
            PG8_LDA(At, 0, 1); PG8_STAGE(PG8_SA(0, 0), a2, voffA);
            PG8_BAR; PG8_WAIT_L(0); PG8_MMA(1, 0, At, B0); PG8_BAR; PG8_SCHED;
            PG8_STAGE(PG8_SB(0, 1), b2 + hstepB, voffB);
            PG8_WAIT_V(6); PG8_BAR; PG8_MMA(1, 1, At, B1); PG8_BAR;
            PG8_LDB(B0, 1, 0); PG8_SCHED; PG8_LDA(At, 1, 0); PG8_STAGE(PG8_SA(0, 1), a2 + hstepA, voffA);
            PG8_WAIT_L(8); PG8_BAR; PG8_WAIT_L(0); PG8_MMA(0, 0, At, B0); PG8_BAR; PG8_SCHED;
            PG8_LDB(B1, 1, 1); PG8_STAGE(PG8_SB(1, 0), b3, voffB);
            PG8_BAR; PG8_WAIT_L(0); PG8_MMA(0, 1, At, B1); PG8_BAR;
            PG8_LDA(At, 1, 1); PG8_STAGE(PG8_SA(1, 0), a3, voffA);
            PG8_BAR; PG8_WAIT_L(0); PG8_MMA(1, 0, At, B0); PG8_BAR; PG8_SCHED;
            PG8_STAGE(PG8_SB(1, 1), b3 + hstepB, voffB);
            PG8_WAIT_V(6); PG8_BAR; PG8_MMA(1, 1, At, B1); PG8_BAR;
        }
        E(acc, cur, wr, wc, fr, fq);
        if (!has_next) break;
#pragma unroll
        for (int a = 0; a < 2; ++a)
#pragma unroll
            for (int b = 0; b < 2; ++b)
#pragma unroll
                for (int m = 0; m < 4; ++m)
#pragma unroll
                    for (int n = 0; n < 2; ++n) acc[a][b][m][n] = (f32x4){0.f, 0.f, 0.f, 0.f};
        cur = nxt; cA = nA; cB = nB; ++ui;
    }
    PG8_WAIT_V(0);
    if (wr == 0) PG8_BAR;
    PG8_BAR;
#undef PG8_SA
#undef PG8_SB
#undef PG8_STAGE
#undef PG8_LDA
#undef PG8_LDB
#undef PG8_MMA
#undef PG8_WAIT_V
#undef PG8_WAIT_L
#undef PG8_BAR
#undef PG8_SCHED
}

struct EpiProj {
    static constexpr bool PERM = true;
    bf16_t* P; const float* rss;
    __device__ __forceinline__ void operator()(const f32x4 (&acc)[2][2][4][2], const Unit& u, int wr, int wc, int fr, int fq) const {
        const int row0 = u.pm * BM + wr * 64 + fr, col0 = u.pn * BM + wc * 32 + 8 * fq;
        const bool sg = (u.pn >= 22) && (u.pn < 46);
        float rsv[2][4];
#pragma unroll
        for (int ai = 0; ai < 2; ++ai)
#pragma unroll
            for (int m = 0; m < 4; ++m) rsv[ai][m] = rss[row0 + ai * HALF + m * 16];
#pragma unroll
        for (int ai = 0; ai < 2; ++ai)
#pragma unroll
            for (int m = 0; m < 4; ++m) { bf16_t* rowp = P + (size_t)(row0 + ai * HALF + m * 16) * NP + col0;
                const float rs = __builtin_amdgcn_rsqf(rsv[ai][m] * (1.0f / DM) + EPS);
#pragma unroll
                for (int bj = 0; bj < 2; ++bj) { f32x4 v0 = acc[ai][bj][m][0] * rs, v1 = acc[ai][bj][m][1] * rs;
                    if (sg) {
#pragma unroll
                        for (int j = 0; j < 4; ++j) { v0[j] = sigmoidf_(v0[j]); v1[j] = sigmoidf_(v1[j]); } }
                    u32x4 w; w.x = cvt_pk_bf16(v0[0], v0[1]); w.y = cvt_pk_bf16(v0[2], v0[3]); w.z = cvt_pk_bf16(v1[0], v1[1]); w.w = cvt_pk_bf16(v1[2], v1[3]);
                    *(u32x4*)(rowp + bj * HALF) = w; } }
    }
};
struct EpiGlu {
    static constexpr bool PERM = true;
    bf16_t* P; const float* bias;
    __device__ __forceinline__ void operator()(const f32x4 (&acc)[2][2][4][2], const Unit& u, int wr, int wc, int fr, int fq) const {
        const int row0 = u.pm * BM + wr * 64 + fr, col0 = u.pn * BM + wc * 32 + 8 * fq;
        f32x4 bv[2][2];
#pragma unroll
        for (int bj = 0; bj < 2; ++bj)
#pragma unroll
            for (int n = 0; n < 2; ++n) bv[bj][n] = *(const f32x4*)(bias + col0 + bj * HALF + 4 * n);
#pragma unroll
        for (int ai = 0; ai < 2; ++ai) {
            u32x4 zw[4][2];
#pragma unroll
            for (int m = 0; m < 4; ++m)
#pragma unroll
                for (int bj = 0; bj < 2; ++bj) zw[m][bj] = *(const u32x4*)(P + (size_t)(row0 + ai * HALF + m * 16) * NP + col0 + C_AQ + bj * HALF);
#pragma unroll
            for (int m = 0; m < 4; ++m) { bf16_t* rowp = P + (size_t)(row0 + ai * HALF + m * 16) * NP + col0;
#pragma unroll
                for (int bj = 0; bj < 2; ++bj) { const f32x4 v0 = acc[ai][bj][m][0] + bv[bj][0], v1 = acc[ai][bj][m][1] + bv[bj][1];
                    float z[8]; unpack8(zw[m][bj], z);
                    float o[8];
#pragma unroll
                    for (int j = 0; j < 4; ++j) { o[j] = z[j] * sigmoidf_(v0[j]); o[4 + j] = z[4 + j] * sigmoidf_(v1[j]); }
                    *(u32x4*)(rowp + C_GQ + bj * HALF) = pack8(o); } }
            asm volatile("" ::: "memory"); }
    }
};
struct EpiBranch {
    static constexpr bool PERM = true;
    const bf16_t* P; bf16_t* MX; int br;
    __device__ __forceinline__ void operator()(const f32x4 (&acc)[2][2][4][2], const Unit& u, int wr, int wc, int fr, int fq) const {
        const int row0 = u.pm * BM + wr * 64 + fr, col0 = u.pn * BM + wc * 32 + 8 * fq;
#pragma unroll
        for (int ai = 0; ai < 2; ++ai) {
            u32x4 gw[4][2], pw[4][2];
#pragma unroll
            for (int m = 0; m < 4; ++m)
#pragma unroll
                for (int bj = 0; bj < 2; ++bj) { const size_t r = (size_t)(row0 + ai * HALF + m * 16);
                    gw[m][bj] = *(const u32x4*)(P + r * NP + C_MERGE + br * 2048 + col0 + bj * HALF);
                    pw[m][bj] = (u32x4){0u, 0u, 0u, 0u};
                    if (br > 0) pw[m][bj] = *(const u32x4*)(MX + r * DM + col0 + bj * HALF); }
#pragma unroll
            for (int m = 0; m < 4; ++m) { const size_t r = (size_t)(row0 + ai * HALF + m * 16);
#pragma unroll
                for (int bj = 0; bj < 2; ++bj) { const f32x4 v0 = acc[ai][bj][m][0], v1 = acc[ai][bj][m][1];
                    float gt[8], pv[8]; unpack8(gw[m][bj], gt); unpack8(pw[m][bj], pv);
                    float o[8];
#pragma unroll
                    for (int j = 0; j < 4; ++j) { o[j] = pv[j] + gt[j] * v0[j]; o[4 + j] = pv[4 + j] + gt[4 + j] * v1[j]; }
                    *(u32x4*)(MX + r * DM + col0 + bj * HALF) = pack8(o); } }
            asm volatile("" ::: "memory"); }
    }
};
struct EpiResid {
    static constexpr bool PERM = false;
    const float* base; float* out; bf16_t* xb; float* rss;
    __device__ __forceinline__ void operator()(const f32x4 (&acc)[2][2][4][2], const Unit& u, int wr, int wc, int fr, int fq) const {
        const int row0 = u.pm * BM + wr * 64 + fr, col0 = u.pn * BM + wc * 32 + 4 * fq;
#pragma unroll
        for (int ai = 0; ai < 2; ++ai) {
            f32x4 bsv[4][2][2];
#pragma unroll
            for (int m = 0; m < 4; ++m)
#pragma unroll
                for (int bj = 0; bj < 2; ++bj)
#pragma unroll
                    for (int n = 0; n < 2; ++n) bsv[m][bj][n] = *(const f32x4*)(base + (size_t)(row0 + ai * HALF + m * 16) * DM + col0 + bj * HALF + n * 16);
#pragma unroll
            for (int m = 0; m < 4; ++m) { const size_t off = (size_t)(row0 + ai * HALF + m * 16) * DM + col0;
                float ss = 0.f;
#pragma unroll
                for (int bj = 0; bj < 2; ++bj)
#pragma unroll
                    for (int n = 0; n < 2; ++n) { const f32x4 o = bsv[m][bj][n] + acc[ai][bj][m][n];
                        *(f32x4*)(out + off + bj * HALF + n * 16) = o;
                        if (xb) { u32x2 w; w.x = cvt_pk_bf16(o[0], o[1]); w.y = cvt_pk_bf16(o[2], o[3]); *(u32x2*)(xb + off + bj * HALF + n * 16) = w;
                            ss += (o[0] * o[0] + o[1] * o[1]) + (o[2] * o[2] + o[3] * o[3]); } }
                if (xb) { ss += __shfl_xor(ss, 16); ss += __shfl_xor(ss, 32);
                    if (fq == 0) atomicAdd(rss + row0 + ai * HALF + m * 16, ss); } }
            asm volatile("" ::: "memory"); }
    }
};
struct EpiRelu2 {
    static constexpr bool PERM = true;
    bf16_t* H; const float* rss;
    __device__ __forceinline__ void operator()(const f32x4 (&acc)[2][2][4][2], const Unit& u, int wr, int wc, int fr, int fq) const {
        const int row0 = u.pm * BM + wr * 64 + fr, col0 = u.pn * BM + wc * 32 + 8 * fq;
        float rsv[2][4];
#pragma unroll
        for (int ai = 0; ai < 2; ++ai)
#pragma unroll
            for (int m = 0; m < 4; ++m) rsv[ai][m] = rss[row0 + ai * HALF + m * 16];
#pragma unroll
        for (int ai = 0; ai < 2; ++ai)
#pragma unroll
            for (int m = 0; m < 4; ++m) { bf16_t* rowp = H + (size_t)(row0 + ai * HALF + m * 16) * DFF + col0;
                const float rs = __builtin_amdgcn_rsqf(rsv[ai][m] * (1.0f / DM) + EPS);
#pragma unroll
                for (int bj = 0; bj < 2; ++bj) { f32x4 v0 = acc[ai][bj][m][0] * rs, v1 = acc[ai][bj][m][1] * rs;
#pragma unroll
                    for (int j = 0; j < 4; ++j) { const float a = fmaxf(v0[j], 0.f), b = fmaxf(v1[j], 0.f); v0[j] = a * a; v1[j] = b * b; }
                    u32x4 w; w.x = cvt_pk_bf16(v0[0], v0[1]); w.y = cvt_pk_bf16(v0[2], v0[3]); w.z = cvt_pk_bf16(v1[0], v1[1]); w.w = cvt_pk_bf16(v1[2], v1[3]);
                    *(u32x4*)(rowp + bj * HALF) = w; } }
    }
};
}

__device__ __forceinline__ void conv_tile(const float* src, int ldsrc, int K, bf16_t* dst, int k0, int n0, bool win, const float* gk, LAS bf16_t* T, int lane) {
    const int nl = (lane & 15) * 4, np = n0 + nl;
    int sc = np; bool valid = true;
    if (win) { if (np < 4608) sc = np; else if (np < 11776) sc = np + 16; else if (np < 11792) sc = np - 11776 + 4608; else valid = false; }
    f32x4 cv[16];
#pragma unroll
    for (int i = 0; i < 16; ++i) { cv[i] = (f32x4){0.f, 0.f, 0.f, 0.f}; if (valid) cv[i] = *(const f32x4*)(src + (size_t)(k0 + i * 4 + (lane >> 4)) * ldsrc + sc); }
    if (gk) {
#pragma unroll
        for (int i = 0; i < 16; ++i) cv[i] = cv[i] * gk[k0 + i * 4 + (lane >> 4)]; }
#pragma unroll
    for (int i = 0; i < 16; ++i) {
        const int kk = i * 4 + (lane >> 4);
        const f32x4 v = cv[i];
        T[(nl + 0) * 72 + kk] = f2bf(v[0]); T[(nl + 1) * 72 + kk] = f2bf(v[1]); T[(nl + 2) * 72 + kk] = f2bf(v[2]); T[(nl + 3) * 72 + kk] = f2bf(v[3]);
    }
    LDS_FENCE();
#pragma unroll
    for (int i = 0; i < 8; ++i) {
        const int n = i * 8 + (lane >> 3), c = lane & 7;
        const u32x4 w = *(const LAS u32x4*)(T + n * 72 + c * 8);
        *(u32x4*)(dst + (size_t)(n0 + n) * K + k0 + c * 8) = w;
    }
    LDS_FENCE();
}

template <bool FFN>
__device__ __forceinline__ void phase_conv(const Params& p, int l, LAS unsigned char* lds, const int wave0 = 0) {
    const int tid = otid(), lane = tid & 63, wid = tid >> 6;
    unsigned char* ws = p.ws;
    if (!FFN && obid() < 8) {
        const int gp = obid() * 512 + tid, g = gp >> 6, pp = gp & 63;
        const double lr = (double)kin(3)[(size_t)l * 4096 + gp], li = (double)kin(4)[(size_t)l * 4096 + gp];
        const double step = exp_d((double)kin(5)[l * 64 + g]);
        const double mag = exp_d(lr * step);
        double sn, cs; sincos_d(li * step, sn, cs);
        const double ar = mag * cs, ai = mag * sn, den = lr * lr + li * li;
        const double fr = ((ar - 1.0) * lr + ai * li) / den, fi = (ai * lr - (ar - 1.0) * li) / den;
        ((f32x2*)(ws + WS_SA))[gp] = (f32x2){(float)ar, (float)ai};
        double pr = ar, pi = ai;
#pragma unroll
        for (int i = 0; i < 6; ++i) { const double nr = pr * pr - pi * pi, ni = 2.0 * pr * pi; pr = nr; pi = ni; }
        ((f32x2*)(ws + WS_SA64))[gp] = (f32x2){(float)pr, (float)pi};
        const float* bre = kin(6) + ((size_t)l * 4096 + gp) * 16; const float* bim = kin(7) + ((size_t)l * 4096 + gp) * 16;
        bf16_t* bb = (bf16_t*)(ws + WS_BB) + (size_t)g * 128 * 16;
#pragma unroll
        for (int c = 0; c < 16; ++c) { const double br = bre[c], bi = bim[c];
            bb[pp * 16 + c] = f2bf((float)(fr * br - fi * bi)); bb[(64 + pp) * 16 + c] = f2bf((float)(fr * bi + fi * br)); }
        const float* cre = kin(8) + ((size_t)l * 64 + g) * 16 * 64; const float* cim = kin(9) + ((size_t)l * 64 + g) * 16 * 64;
        bf16_t* cc = (bf16_t*)(ws + WS_CC) + (size_t)g * 16 * 128;
#pragma unroll
        for (int c = 0; c < 16; ++c) { cc[c * 128 + pp] = f2bf(cre[c * 64 + pp]); cc[c * 128 + 64 + pp] = f2bf(-cim[c * 64 + pp]); }
    }
    if (!FFN && l == 0) {
        float* rt = (float*)(ws + WS_ROPE);
        for (int idx = obid() * 512 + tid; idx < SEQ * 32; idx += gridDim.x * 512) {
            const int pos = idx >> 5, i = idx & 31;
            const float inv = (float)exp_d(-(double)i * (9.21034037197618273607 / 32.0));
            const float ang = (float)pos * inv;
            double sn, cs; sincos_d((double)ang, sn, cs);
            rt[pos * 64 + i] = (float)cs; rt[pos * 64 + 32 + i] = (float)sn;
        }
    }
    LAS bf16_t* T = (LAS bf16_t*)(lds + wid * 9216);
    if (wid < wave0) return;
    const int gw = (wid - wave0) * gridDim.x + obid(), nw = gridDim.x * (8 - wave0);
    const int ntile[8] = {32 * 188, 16 * 16, 16 * 32, 16 * 32, 16 * 32, 32 * 32, 32 * 128, 128 * 32};
    int total = 0;
#pragma unroll
    for (int i = 0; i < 8; ++i) total += ntile[i];
    const int first6 = ntile[0] + ntile[1] + ntile[2] + ntile[3] + ntile[4] + ntile[5];
    for (int it = (FFN ? first6 : 0) + gw; it < (FFN ? total : first6); it += nw) {
        int r = it, mi = 0;
#pragma unroll
        for (int i = 0; i < 7; ++i) { if (mi == i && r >= ntile[i]) { r -= ntile[i]; mi = i + 1; } }
        const float* src; bf16_t* dst; int K, N, ldsrc; bool win = false; const float* gk = nullptr;
        switch (mi) {
            case 0: src = kin(2) + (size_t)l * DM * IN_W; dst = (bf16_t*)(ws + WS_WIN); K = DM; N = NP; ldsrc = IN_W; win = true; gk = kin(1) + (size_t)l * DM; break;
            case 1: src = kin(11) + (size_t)l * 1024 * 1024; dst = (bf16_t*)(ws + WS_WGLU); K = 1024; N = 1024; ldsrc = 1024; break;
            case 2: src = kin(17) + (size_t)l * 1024 * DM; dst = (bf16_t*)(ws + WS_WBS); K = 1024; N = DM; ldsrc = DM; break;
            case 3: src = kin(18) + (size_t)l * 1024 * DM; dst = (bf16_t*)(ws + WS_WBA); K = 1024; N = DM; ldsrc = DM; break;
            case 4: src = kin(19) + (size_t)l * 1024 * DM; dst = (bf16_t*)(ws + WS_WBG); K = 1024; N = DM; ldsrc = DM; break;
            case 5: src = kin(20) + (size_t)l * DM * DM; dst = (bf16_t*)(ws + WS_WOUT); K = DM; N = DM; ldsrc = DM; break;
            case 6: src = kin(22) + (size_t)l * DM * DFF; dst = (bf16_t*)(ws + WS_WFF1); K = DM; N = DFF; ldsrc = DFF; gk = kin(21) + (size_t)l * DM; break;
            default: src = kin(23) + (size_t)l * DFF * DM; dst = (bf16_t*)(ws + WS_WFF2); K = DFF; N = DM; ldsrc = DM; break;
        }
        const int nnt = N / 64, kt = r / nnt, ntl = r % nnt;
        conv_tile(src, ldsrc, K, dst, kt * 64, ntl * 64, win, gk, T, lane);
    }
}

template <bool TO_BF16>
__device__ __forceinline__ void phase_norm(const float* x, const float* g, bf16_t* hb, float* outf) {
    const int lane = otid() & 63, wid = otid() >> 6;
    const int gw = obid() * 8 + wid, nw = gridDim.x * 8;
    for (int row = gw; row < SEQ; row += nw) {
        const f32x4* xr = (const f32x4*)(x + (size_t)row * DM) + lane;
        f32x4 v[8]; float s = 0.f;
#pragma unroll
        for (int j = 0; j < 8; ++j) { v[j] = xr[64 * j]; s += (v[j][0] * v[j][0] + v[j][1] * v[j][1]) + (v[j][2] * v[j][2] + v[j][3] * v[j][3]); }
        s = wave_sum(s);
        const float rs = 1.0f / sqrtf(s * (1.0f / DM) + EPS);
#pragma unroll
        for (int j = 0; j < 8; ++j) {
            const f32x4 gv = *((const f32x4*)g + lane + 64 * j);
            const f32x4 o = v[j] * rs * gv;
            if (TO_BF16) { u32x2 w; w.x = cvt_pk_bf16(o[0], o[1]); w.y = cvt_pk_bf16(o[2], o[3]); *((u32x2*)(hb + (size_t)row * DM) + lane + 64 * j) = w; }
            else *((f32x4*)(outf + (size_t)row * DM) + lane + 64 * j) = o;
        }
    }
}

__device__ __forceinline__ void phase_xb(const float* x, bf16_t* xb, float* rss) {
    const int lane = otid() & 63, wid = otid() >> 6;
    const int gw = obid() * 8 + wid, nw = gridDim.x * 8;
    for (int row = gw; row < SEQ; row += nw) {
        const f32x4* xr = (const f32x4*)(x + (size_t)row * DM) + lane;
        f32x4 v[8]; float s = 0.f;
#pragma unroll
        for (int j = 0; j < 8; ++j) { v[j] = xr[64 * j]; s += (v[j][0] * v[j][0] + v[j][1] * v[j][1]) + (v[j][2] * v[j][2] + v[j][3] * v[j][3]); }
        s = wave_sum(s);
        if (lane == 0) rss[row] = s;
#pragma unroll
        for (int j = 0; j < 8; ++j) { u32x2 w; w.x = cvt_pk_bf16(v[j][0], v[j][1]); w.y = cvt_pk_bf16(v[j][2], v[j][3]); *((u32x2*)(xb + (size_t)row * DM) + lane + 64 * j) = w; }
    }
}

__device__ __forceinline__ void swa_item(const bf16_t* P, bf16_t* YA, const float* rope, const float* sinks, int n, int kvh, LAS unsigned char* lds) {
    const int tid = otid(), lane = tid & 63, wid = tid >> 6, l15 = lane & 15, g4 = lane >> 4;
    LAS bf16_t* Ks = (LAS bf16_t*)lds;
    LAS bf16_t* Vt = (LAS bf16_t*)(lds + 36864);
    {
        const int j = tid >> 1, hf = tid & 1, row = n * 128 - 128 + j;
        float o1[16], o2[16];
        if (row >= 0) {
            const bf16_t* kp = P + (size_t)row * NP + C_AK + kvh * 64 + hf * 16;
            const u32x4 a0 = *(const u32x4*)kp, a1 = *(const u32x4*)(kp + 8), b0 = *(const u32x4*)(kp + 32), b1 = *(const u32x4*)(kp + 40);
            float x1[16], x2[16];
            { float t[8]; unpack8(a0, t);
#pragma unroll
              for (int i = 0; i < 8; ++i) x1[i] = t[i]; unpack8(a1, t);
#pragma unroll
              for (int i = 0; i < 8; ++i) x1[8 + i] = t[i]; unpack8(b0, t);
#pragma unroll
              for (int i = 0; i < 8; ++i) x2[i] = t[i]; unpack8(b1, t);
#pragma unroll
              for (int i = 0; i < 8; ++i) x2[8 + i] = t[i]; }
            const float* rp = rope + (size_t)row * 64 + hf * 16;
#pragma unroll
            for (int i = 0; i < 16; i += 4) { const f32x4 c = *(const f32x4*)(rp + i), s = *(const f32x4*)(rp + 32 + i);
#pragma unroll
                for (int e = 0; e < 4; ++e) { o1[i + e] = x1[i + e] * c[e] - x2[i + e] * s[e]; o2[i + e] = x2[i + e] * c[e] + x1[i + e] * s[e]; } }
        } else {
#pragma unroll
            for (int i = 0; i < 16; ++i) { o1[i] = 0.f; o2[i] = 0.f; }
        }
        { float t[8];
#pragma unroll
          for (int i = 0; i < 8; ++i) t[i] = o1[i]; *(LAS u32x4*)(Ks + j * 72 + hf * 16) = pack8(t);
#pragma unroll
          for (int i = 0; i < 8; ++i) t[i] = o1[8 + i]; *(LAS u32x4*)(Ks + j * 72 + hf * 16 + 8) = pack8(t);
#pragma unroll
          for (int i = 0; i < 8; ++i) t[i] = o2[i]; *(LAS u32x4*)(Ks + j * 72 + 32 + hf * 16) = pack8(t);
#pragma unroll
          for (int i = 0; i < 8; ++i) t[i] = o2[8 + i]; *(LAS u32x4*)(Ks + j * 72 + 32 + hf * 16 + 8) = pack8(t); }
        const bf16_t* vp = P + (size_t)(row < 0 ? 0 : row) * NP + C_AV + kvh * 64 + hf * 32;
#pragma unroll
        for (int q = 0; q < 4; ++q) { u32x4 w = *(const u32x4*)(vp + q * 8); if (row < 0) w = (u32x4){0u, 0u, 0u, 0u};
            const int d0 = hf * 32 + q * 8;
            Vt[(d0 + 0) * 264 + j] = (bf16_t)(w.x & 0xffffu); Vt[(d0 + 1) * 264 + j] = (bf16_t)(w.x >> 16);
            Vt[(d0 + 2) * 264 + j] = (bf16_t)(w.y & 0xffffu); Vt[(d0 + 3) * 264 + j] = (bf16_t)(w.y >> 16);
            Vt[(d0 + 4) * 264 + j] = (bf16_t)(w.z & 0xffffu); Vt[(d0 + 5) * 264 + j] = (bf16_t)(w.z >> 16);
            Vt[(d0 + 6) * 264 + j] = (bf16_t)(w.w & 0xffffu); Vt[(d0 + 7) * 264 + j] = (bf16_t)(w.w >> 16); }
    }
    const int hq = kvh * 4 + (wid >> 1);
    const float sink = sinks[hq];
    u32x4 nw1, nw2; f32x4 nc0, nc1, ns0, ns1;
#define SWA_QLOAD(QT) do { const int qrow_ = n * 128 + (wid & 1) * 64 + (QT) * 16 + l15; const bf16_t* qp_ = P + (size_t)qrow_ * NP + C_AQ + hq * 64 + g4 * 8; \
        nw1 = *(const u32x4*)qp_; nw2 = *(const u32x4*)(qp_ + 32); const float* rp_ = rope + (size_t)qrow_ * 64 + g4 * 8; \
        nc0 = *(const f32x4*)rp_; nc1 = *(const f32x4*)(rp_ + 4); ns0 = *(const f32x4*)(rp_ + 32); ns1 = *(const f32x4*)(rp_ + 36); } while (0)
    SWA_QLOAD(0);
    __syncthreads();
    for (int qt = 0; qt < 4; ++qt) {
        const int i0 = (wid & 1) * 64 + qt * 16;
        bf16x8 qa0, qa1;
        {   const u32x4 w1 = nw1, w2 = nw2; const f32x4 c0 = nc0, c1 = nc1, s0 = ns0, s1 = ns1;
            if (qt + 1 < 4) SWA_QLOAD(qt + 1);
            float x1[8], x2[8], r1[8], r2[8]; unpack8(w1, x1); unpack8(w2, x2);
#pragma unroll
            for (int e = 0; e < 4; ++e) {
                r1[e] = (x1[e] * c0[e] - x2[e] * s0[e]) * 0.125f; r2[e] = (x2[e] * c0[e] + x1[e] * s0[e]) * 0.125f;
                r1[4 + e] = (x1[4 + e] * c1[e] - x2[4 + e] * s1[e]) * 0.125f; r2[4 + e] = (x2[4 + e] * c1[e] + x1[4 + e] * s1[e]) * 0.125f; }
            qa0 = as_bf16x8(pack8(r1)); qa1 = as_bf16x8(pack8(r2)); }
        const int kt0 = i0 >> 4;
        f32x4 sc[9];
#pragma unroll
        for (int t = 0; t < 9; ++t) {
            const LAS bf16_t* kp = Ks + ((kt0 + t) * 16 + l15) * 72 + g4 * 8;
            const bf16x8 k0 = *(const LAS bf16x8*)kp, k1 = *(const LAS bf16x8*)(kp + 32);
            f32x4 a = (f32x4){0.f, 0.f, 0.f, 0.f};
            a = MFMA16(k0, qa0, a); a = MFMA16(k1, qa1, a);
            sc[t] = a;
        }
        const int qi = i0 + l15;
        float mx = sink;
#pragma unroll
        for (int t = 0; t < 9; ++t)
#pragma unroll
            for (int jj = 0; jj < 4; ++jj) { const int j = (kt0 + t) * 16 + g4 * 4 + jj;
                const bool ok = (j > qi) && (j <= qi + 128) && (n * 128 - 128 + j >= 0);
                sc[t][jj] = ok ? sc[t][jj] : -INFINITY; mx = fmaxf(mx, sc[t][jj]); }
        mx = fmaxf(mx, __shfl_xor(mx, 16)); mx = fmaxf(mx, __shfl_xor(mx, 32));
        float sum = 0.f;
#pragma unroll
        for (int t = 0; t < 9; ++t)
#pragma unroll
            for (int jj = 0; jj < 4; ++jj) { const float e = __expf(sc[t][jj] - mx); sc[t][jj] = e; sum += e; }
        sum += __shfl_xor(sum, 16); sum += __shfl_xor(sum, 32);
        sum += __expf(sink - mx);
        const float inv = 1.0f / sum;
        f32x4 o[4];
#pragma unroll
        for (int dt = 0; dt < 4; ++dt) o[dt] = (f32x4){0.f, 0.f, 0.f, 0.f};
#pragma unroll
        for (int pr = 0; pr < 5; ++pr) {
            const int ta = 2 * pr, tb = 2 * pr + 1;
            u32x4 pw; pw.x = cvt_pk_bf16(sc[ta][0] * inv, sc[ta][1] * inv); pw.y = cvt_pk_bf16(sc[ta][2] * inv, sc[ta][3] * inv);
            if (tb < 9) { pw.z = cvt_pk_bf16(sc[tb < 9 ? tb : 8][0] * inv, sc[tb < 9 ? tb : 8][1] * inv); pw.w = cvt_pk_bf16(sc[tb < 9 ? tb : 8][2] * inv, sc[tb < 9 ? tb : 8][3] * inv); }
            else { pw.z = 0u; pw.w = 0u; }
            const bf16x8 pa = as_bf16x8(pw);
#pragma unroll
            for (int dt = 0; dt < 4; ++dt) {
                const LAS bf16_t* vp = Vt + (dt * 16 + l15) * 264 + (kt0 + ta) * 16 + g4 * 4;
                u32x4 vw; const u32x2 va = *(const LAS u32x2*)vp; vw.x = va.x; vw.y = va.y;
                if (tb < 9) { const u32x2 vb = *(const LAS u32x2*)(vp + 16); vw.z = vb.x; vw.w = vb.y; } else { vw.z = 0u; vw.w = 0u; }
                o[dt] = MFMA16(pa, as_bf16x8(vw), o[dt]);
            }
        }
#pragma unroll
        for (int dt = 0; dt < 4; ++dt)
#pragma unroll
            for (int jj = 0; jj < 4; ++jj)
                YA[(size_t)(n * 128 + i0 + g4 * 4 + jj) * 1024 + hq * 64 + dt * 16 + l15] = f2bf(o[dt][jj]);
    }
    __syncthreads();
}

#undef SWA_QLOAD
__device__ __forceinline__ void gla_bcum(const bf16_t* P, const float* wgate, const float* bgate, int n, int h, LAS float* bc, LAS float* glr_s, LAS float* wg_s) {
    const int tid = otid();
    if (tid < 128) { const int t = tid >> 1, r0 = (tid & 1) * 8;
        const u32x4 w = *(const u32x4*)(P + (size_t)(n * 64 + t) * NP + C_GLR + r0); float f[8]; unpack8(w, f);
#pragma unroll
        for (int i = 0; i < 8; ++i) glr_s[t * 16 + r0 + i] = f[i]; }
    { const int r = tid >> 5, d0 = (tid & 31) * 4; const f32x4 w = *(const f32x4*)(wgate + r * 512 + h * 128 + d0);
      *(LAS f32x4*)(wg_s + r * 128 + d0) = w; }
    __syncthreads();
    const int d = tid & 127, tq = tid >> 7;
    float wreg[16];
#pragma unroll
    for (int r = 0; r < 16; ++r) wreg[r] = wg_s[r * 128 + d];
    const float bias = bgate[h * 128 + d];
    float c = 0.f;
    for (int tt = 0; tt < 16; ++tt) { const int t = tq * 16 + tt;
        float z = bias;
#pragma unroll
        for (int r = 0; r < 16; r += 4) { const f32x4 gv = *(const LAS f32x4*)(glr_s + t * 16 + r); z += gv[0] * wreg[r] + gv[1] * wreg[r + 1] + gv[2] * wreg[r + 2] + gv[3] * wreg[r + 3]; }
        const float ls = fminf(z, 0.f) - __logf(1.0f + __expf(-fabsf(z)));
        c += ls * (1.0f / 16.0f);
        bc[t * 128 + d] = c; }
    __syncthreads();
    float off = 0.f;
    for (int q = 0; q < tq; ++q) off += bc[(q * 16 + 15) * 128 + d];
    __syncthreads();
    if (tq > 0) { for (int tt = 0; tt < 16; ++tt) bc[(tq * 16 + tt) * 128 + d] += off; }
    __syncthreads();
}
__device__ __forceinline__ void gla_stage_vt(const bf16_t* P, int n, int h, LAS bf16_t* Vt) {
    const int tid = otid(), t = tid >> 3, e0 = (tid & 7) * 32;
    const bf16_t* vp = P + (size_t)(n * 64 + t) * NP + C_GV + h * 256 + e0;
#pragma unroll
    for (int q = 0; q < 4; ++q) { const u32x4 w = *(const u32x4*)(vp + q * 8); const int e = e0 + q * 8;
        Vt[(e + 0) * 72 + t] = (bf16_t)(w.x & 0xffffu); Vt[(e + 1) * 72 + t] = (bf16_t)(w.x >> 16);
        Vt[(e + 2) * 72 + t] = (bf16_t)(w.y & 0xffffu); Vt[(e + 3) * 72 + t] = (bf16_t)(w.y >> 16);
        Vt[(e + 4) * 72 + t] = (bf16_t)(w.z & 0xffffu); Vt[(e + 5) * 72 + t] = (bf16_t)(w.z >> 16);
        Vt[(e + 6) * 72 + t] = (bf16_t)(w.w & 0xffffu); Vt[(e + 7) * 72 + t] = (bf16_t)(w.w >> 16); }
}

__device__ __forceinline__ void gla_store_vt(const u32x4 (&rv)[4], int t, int e0, LAS bf16_t* Vt) {
#pragma unroll
    for (int q = 0; q < 4; ++q) { const u32x4 w = rv[q]; const int e = e0 + q * 8;
        Vt[(e + 0) * 72 + t] = (bf16_t)(w.x & 0xffffu); Vt[(e + 1) * 72 + t] = (bf16_t)(w.x >> 16);
        Vt[(e + 2) * 72 + t] = (bf16_t)(w.y & 0xffffu); Vt[(e + 3) * 72 + t] = (bf16_t)(w.y >> 16);
        Vt[(e + 4) * 72 + t] = (bf16_t)(w.z & 0xffffu); Vt[(e + 5) * 72 + t] = (bf16_t)(w.z >> 16);
        Vt[(e + 6) * 72 + t] = (bf16_t)(w.w & 0xffffu); Vt[(e + 7) * 72 + t] = (bf16_t)(w.w >> 16); }
}

__device__ __forceinline__ void gla_pass1_item(const Params& p, int l, int n, int h, LAS unsigned char* lds) {
    const int tid = otid(), lane = tid & 63, wid = tid >> 6, l15 = lane & 15, g4 = lane >> 4;
    const bf16_t* P = (const bf16_t*)(p.ws + WS_P);
    LAS float* bc = (LAS float*)lds;
    LAS bf16_t* KdT = (LAS bf16_t*)(lds + 32768);
    LAS bf16_t* Vt = (LAS bf16_t*)(lds + 51200);
    LAS float* glr_s = (LAS float*)(lds + 88064);
    LAS float* wg_s = (LAS float*)(lds + 92160);
    const int st = tid >> 3, sd0 = (tid & 7) * 16, se0 = (tid & 7) * 32;
    const bf16_t* rowp = P + (size_t)(n * 64 + st) * NP;
    u32x4 rk[2], rv[4];
#pragma unroll
    for (int q = 0; q < 2; ++q) rk[q] = *(const u32x4*)(rowp + C_GK + h * 128 + sd0 + q * 8);
#pragma unroll
    for (int q = 0; q < 4; ++q) rv[q] = *(const u32x4*)(rowp + C_GV + h * 256 + se0 + q * 8);
    gla_bcum(P, kin(14) + (size_t)l * 16 * 512, kin(15) + (size_t)l * 512, n, h, bc, glr_s, wg_s);
    if (tid < 128) ((float*)(p.ws + WS_GDEC))[(size_t)(n * 4 + h) * 128 + tid] = __expf(bc[63 * 128 + tid]);
#pragma unroll
    for (int q = 0; q < 2; ++q) { float f[8]; unpack8(rk[q], f);
#pragma unroll
        for (int i = 0; i < 8; ++i) { const int d = sd0 + q * 8 + i; KdT[d * 72 + st] = f2bf(f[i] * __expf(bc[63 * 128 + d] - bc[st * 128 + d])); } }
    gla_store_vt(rv, st, se0, Vt);
    __syncthreads();
    bf16_t* GS = (bf16_t*)(p.ws + WS_GS) + (size_t)(n * 4 + h) * 256 * 128;
#pragma unroll
    for (int ei = 0; ei < 2; ++ei) { const int et = wid * 2 + ei;
        bf16x8 vf[2];
#pragma unroll
        for (int ks = 0; ks < 2; ++ks) vf[ks] = *(const LAS bf16x8*)(Vt + (et * 16 + l15) * 72 + ks * 32 + g4 * 8);
#pragma unroll
        for (int dt = 0; dt < 8; ++dt) {
            f32x4 a = (f32x4){0.f, 0.f, 0.f, 0.f};
#pragma unroll
            for (int ks = 0; ks < 2; ++ks) { const bf16x8 kf = *(const LAS bf16x8*)(KdT + (dt * 16 + l15) * 72 + ks * 32 + g4 * 8);
                a = MFMA16(kf, vf[ks], a); }
            u32x2 w; w.x = cvt_pk_bf16(a[0], a[1]); w.y = cvt_pk_bf16(a[2], a[3]);
            *(u32x2*)(GS + (size_t)(et * 16 + l15) * 128 + dt * 16 + g4 * 4) = w;
        } }
    __syncthreads();
}

__device__ __forceinline__ void gla_pass3_item(const Params& p, int l, int n, int h, LAS unsigned char* lds) {
    const int tid = otid(), lane = tid & 63, wid = tid >> 6, l15 = lane & 15, g4 = lane >> 4;
    const bf16_t* P = (const bf16_t*)(p.ws + WS_P);
    LAS float* bc = (LAS float*)lds;
    LAS bf16_t* Gs = (LAS bf16_t*)lds;
    LAS bf16_t* Qs = (LAS bf16_t*)(lds + 32768);
    LAS bf16_t* Kn = (LAS bf16_t*)(lds + 50176);
    LAS bf16_t* Vt = (LAS bf16_t*)(lds + 67584);
    LAS bf16_t* At = (LAS bf16_t*)(lds + 104448);
    LAS float* glr_s = (LAS float*)(lds + 113664);
    LAS float* wg_s = (LAS float*)(lds + 117760);
    LAS float* ssq = (LAS float*)(lds + 125952);
    const int st = tid >> 3, sd0 = (tid & 7) * 16, se0 = (tid & 7) * 32;
    const bf16_t* rowp = P + (size_t)(n * 64 + st) * NP;
    u32x4 rq[2], rk[2], rv[4], rg[4];
#pragma unroll
    for (int q = 0; q < 2; ++q) { rq[q] = *(const u32x4*)(rowp + C_GQ + h * 128 + sd0 + q * 8); rk[q] = *(const u32x4*)(rowp + C_GK + h * 128 + sd0 + q * 8); }
#pragma unroll
    for (int q = 0; q < 4; ++q) { rv[q] = *(const u32x4*)(rowp + C_GV + h * 256 + se0 + q * 8); rg[q] = *(const u32x4*)(rowp + C_GOUT + h * 256 + se0 + q * 8); }
    gla_bcum(P, kin(14) + (size_t)l * 16 * 512, kin(15) + (size_t)l * 512, n, h, bc, glr_s, wg_s);
#pragma unroll
    for (int q = 0; q < 2; ++q) { float fq_[8], fk[8]; unpack8(rq[q], fq_); unpack8(rk[q], fk);
#pragma unroll
        for (int i = 0; i < 8; ++i) { const float b = bc[st * 128 + sd0 + q * 8 + i]; fq_[i] = fq_[i] * 0.08838834764831845f * __expf(b); fk[i] = fk[i] * __expf(-b); }
        *(LAS u32x4*)(Qs + st * 136 + sd0 + q * 8) = pack8(fq_); *(LAS u32x4*)(Kn + st * 136 + sd0 + q * 8) = pack8(fk); }
    gla_store_vt(rv, st, se0, Vt);
    __syncthreads();
    const bf16_t* GS = (const bf16_t*)(p.ws + WS_GST) + (size_t)(n * 4 + h) * 256 * 128;
    bf16x8 sf[2][4];
#pragma unroll
    for (int ei = 0; ei < 2; ++ei)
#pragma unroll
        for (int ks = 0; ks < 4; ++ks) sf[ei][ks] = *(const bf16x8*)(GS + (size_t)((wid * 2 + ei) * 16 + l15) * 128 + ks * 32 + g4 * 8);
    const float* ng = kin(16) + (size_t)l * 1024 + h * 256;
    float ngv[2];
#pragma unroll
    for (int ei = 0; ei < 2; ++ei) ngv[ei] = ng[(wid * 2 + ei) * 16 + l15];
#pragma unroll
    for (int q = 0; q < 4; ++q) *(LAS u32x4*)(Gs + st * 256 + se0 + q * 8) = rg[q];
#pragma unroll
    for (int ii = 0; ii < 2; ++ii) { const int id = wid * 2 + ii, ti = id >> 2, tj = id & 3;
        f32x4 a = (f32x4){0.f, 0.f, 0.f, 0.f};
        if (tj <= ti) {
#pragma unroll
            for (int ks = 0; ks < 4; ++ks) { const bf16x8 qf = *(const LAS bf16x8*)(Qs + (ti * 16 + l15) * 136 + ks * 32 + g4 * 8);
                const bf16x8 kf = *(const LAS bf16x8*)(Kn + (tj * 16 + l15) * 136 + ks * 32 + g4 * 8);
                a = MFMA16(qf, kf, a); }
            if (tj == ti) {
#pragma unroll
                for (int jj = 0; jj < 4; ++jj) if (g4 * 4 + jj < l15) a[jj] = 0.f; }
        }
#pragma unroll
        for (int jj = 0; jj < 4; ++jj) At[(ti * 16 + g4 * 4 + jj) * 72 + tj * 16 + l15] = f2bf(a[jj]); }
    __syncthreads();
    f32x4 o[2][4];
#pragma unroll
    for (int ei = 0; ei < 2; ++ei) { const int et = wid * 2 + ei;
        bf16x8 vf[2];
#pragma unroll
        for (int ks = 0; ks < 2; ++ks) vf[ks] = *(const LAS bf16x8*)(Vt + (et * 16 + l15) * 72 + ks * 32 + g4 * 8);
#pragma unroll
        for (int ti = 0; ti < 4; ++ti) {
            f32x4 a = (f32x4){0.f, 0.f, 0.f, 0.f};
#pragma unroll
            for (int ks = 0; ks < 4; ++ks) { const bf16x8 qf = *(const LAS bf16x8*)(Qs + (ti * 16 + l15) * 136 + ks * 32 + g4 * 8); a = MFMA16(qf, sf[ei][ks], a); }
#pragma unroll
            for (int ks = 0; ks < 2; ++ks) if (ks * 32 <= ti * 16 + 15) { const bf16x8 af = *(const LAS bf16x8*)(At + (ti * 16 + l15) * 72 + ks * 32 + g4 * 8); a = MFMA16(af, vf[ks], a); }
            o[ei][ti] = a;
        } }
#pragma unroll
    for (int ti = 0; ti < 4; ++ti)
#pragma unroll
        for (int jj = 0; jj < 4; ++jj) { float s = o[0][ti][jj] * o[0][ti][jj] + o[1][ti][jj] * o[1][ti][jj];
            s += __shfl_xor(s, 1); s += __shfl_xor(s, 2); s += __shfl_xor(s, 4); s += __shfl_xor(s, 8);
            if (l15 == 0) ssq[wid * 64 + ti * 16 + g4 * 4 + jj] = s; }
    __syncthreads();
    bf16_t* YG = (bf16_t*)(p.ws + WS_YG);
#pragma unroll
    for (int ti = 0; ti < 4; ++ti)
#pragma unroll
        for (int jj = 0; jj < 4; ++jj) { const int t = ti * 16 + g4 * 4 + jj;
            float tot = 0.f;
#pragma unroll
            for (int w = 0; w < 8; ++w) tot += ssq[w * 64 + t];
            const float rs = __builtin_amdgcn_rsqf(tot * (1.0f / 256.0f) + EPS);
#pragma unroll
            for (int ei = 0; ei < 2; ++ei) { const int e = (wid * 2 + ei) * 16 + l15;
                const float gt = bf2f(Gs[t * 256 + e]);
                const float v = o[ei][ti][jj] * rs * ngv[ei] * (gt * sigmoidf_(gt));
                YG[(size_t)(n * 64 + t) * 1024 + h * 256 + e] = f2bf(v); } }
    __syncthreads();
}

template <bool FINAL>
__device__ __forceinline__ void s5_pass(const Params& p, int l, LAS unsigned char* lds) {
    const int tid = otid(), lane = tid & 63, wid = tid >> 6, l15 = lane & 15, g4 = lane >> 4;
    bf16_t* P = (bf16_t*)(p.ws + WS_P);
    LAS float* X = (LAS float*)(lds + wid * 12800);
    LAS bf16_t* H = (LAS bf16_t*)(lds + wid * 12800 + 8448);
    const int bid_ = obid();
    const int g = (bid_ & 15) * 4 + (wid & 3), nb = (bid_ >> 4) * 2 + (wid >> 2);
    const bf16_t* bb = (const bf16_t*)(p.ws + WS_BB) + (size_t)g * 128 * 16;
    bf16x8 bf[8];
#pragma unroll
    for (int pt = 0; pt < 8; ++pt) { u32x4 w = (u32x4){0u, 0u, 0u, 0u}; if (g4 < 2) w = *(const u32x4*)(bb + (pt * 16 + l15) * 16 + g4 * 8); bf[pt] = as_bf16x8(w); }
    const f32x2 A = ((const f32x2*)(p.ws + WS_SA))[g * 64 + lane];
    bf16x8 cf[4], idB; float dsk = 0.f;
    if (FINAL) { const bf16_t* cc = (const bf16_t*)(p.ws + WS_CC) + (size_t)g * 16 * 128;
#pragma unroll
        for (int ks = 0; ks < 4; ++ks) cf[ks] = *(const bf16x8*)(cc + l15 * 128 + ks * 32 + g4 * 8);
        dsk = kin(10)[(size_t)l * 1024 + g * 16 + l15];
        unsigned e[8];
#pragma unroll
        for (int j = 0; j < 8; ++j) e[j] = (g4 * 8 + j == l15) ? 0x3F80u : 0u;
        u32x4 w; w.x = e[0] | (e[1] << 16); w.y = e[2] | (e[3] << 16); w.z = e[4] | (e[5] << 16); w.w = e[6] | (e[7] << 16);
        idB = as_bf16x8(w); }
    f32x2* S5C = (f32x2*)(p.ws + WS_S5C);
    const f32x2* S5S = (const f32x2*)(p.ws + WS_S5S);
    const bf16_t* ubase = P + (size_t)l15 * NP + C_U + g * 16 + g4 * 8;
#define S5_TROW(q) ((size_t)(nb + 32 * ((q) >> 2)) * 64 + (size_t)(((q) & 3) * 16))
    u32x4 unext = (u32x4){0u, 0u, 0u, 0u};
    if (g4 < 2) unext = *(const u32x4*)(ubase + S5_TROW(0) * NP);
    f32x2 s0next = (f32x2){0.f, 0.f};
    if (FINAL) s0next = S5S[((size_t)nb * 64 + g) * 64 + lane];
    float sr = 0.f, si = 0.f;
    for (int q = 0; q < 32; ++q) {
        const size_t trow = S5_TROW(q);
        const int n = nb + 32 * (q >> 2);
        const bf16x8 ua = as_bf16x8(unext);
        if (q + 1 < 32) { u32x4 t = (u32x4){0u, 0u, 0u, 0u}; if (g4 < 2) t = *(const u32x4*)(ubase + S5_TROW(q + 1) * NP); unext = t; }
        if ((q & 3) == 0) { sr = FINAL ? s0next.x : 0.f; si = FINAL ? s0next.y : 0.f;
            if (FINAL && q + 4 < 32) s0next = S5S[((size_t)(n + 32) * 64 + g) * 64 + lane]; }
#pragma unroll
        for (int pt = 0; pt < 8; ++pt) { f32x4 d = (f32x4){0.f, 0.f, 0.f, 0.f}; d = MFMA16(ua, bf[pt], d);
#pragma unroll
            for (int jj = 0; jj < 4; ++jj) X[(g4 * 4 + jj) * 132 + pt * 16 + l15] = d[jj]; }
        f32x4 uD = (f32x4){0.f, 0.f, 0.f, 0.f};
        if (FINAL) uD = MFMA16(ua, idB, uD);
        LDS_FENCE();
#pragma unroll
        for (int t = 0; t < 16; ++t) { const float xr = X[t * 132 + lane], xi = X[t * 132 + 64 + lane];
            cplx_step(A, sr, si, xr, xi);
            if (FINAL) { H[t * 136 + lane] = f2bf(sr); H[t * 136 + 64 + lane] = f2bf(si); } }
        LDS_FENCE();
        if (FINAL) {
            f32x4 y = (f32x4){0.f, 0.f, 0.f, 0.f};
#pragma unroll
            for (int ks = 0; ks < 4; ++ks) { const bf16x8 hf = *(const LAS bf16x8*)(H + l15 * 136 + ks * 32 + g4 * 8); y = MFMA16(hf, cf[ks], y); }
#pragma unroll
            for (int jj = 0; jj < 4; ++jj) {
                const float yv = y[jj] + dsk * uD[jj];
                const float inner = 0.7978845608028654f * (yv + 0.044715f * yv * yv * yv);
                const float z = yv * sigmoidf_(2.0f * inner);
                P[(trow + g4 * 4 + jj) * NP + C_AQ + g * 16 + l15] = f2bf(z); }
            LDS_FENCE();
        }
        if (!FINAL && (q & 3) == 3) S5C[((size_t)n * 64 + g) * 64 + lane] = (f32x2){sr, si};
    }
#undef S5_TROW
}

__device__ __forceinline__ void phase_scan(const Params& p) {
    const int tid = otid(), lane = tid & 63, wid = tid >> 6;
    const int gw = wid * gridDim.x + obid();
    if (gw < 1024) {
        const int idx = gw * 64 + lane, h = idx >> 14, e = (idx >> 6) & 255, dp = idx & 63;
        const unsigned* gs = (const unsigned*)(p.ws + WS_GS) + ((size_t)(h * 256 + e) * 128 + dp * 2) / 2;
        unsigned* gst = (unsigned*)(p.ws + WS_GST) + ((size_t)(h * 256 + e) * 128 + dp * 2) / 2;
        const f32x2* dec = (const f32x2*)(p.ws + WS_GDEC) + ((size_t)h * 128 + dp * 2) / 2;
        float s0 = 0.f, s1 = 0.f;
        unsigned un[16]; f32x2 dn[16];
#pragma unroll
        for (int j = 0; j < 16; ++j) { un[j] = gs[(size_t)j * (4 * 256 * 128 / 2)]; dn[j] = dec[(size_t)j * (4 * 128 / 2)]; }
        for (int n0 = 0; n0 < 256; n0 += 16) {
            unsigned u[16]; f32x2 dc[16];
#pragma unroll
            for (int j = 0; j < 16; ++j) { u[j] = un[j]; dc[j] = dn[j]; }
            if (n0 + 16 < 256) {
#pragma unroll
                for (int j = 0; j < 16; ++j) { un[j] = gs[(size_t)(n0 + 16 + j) * (4 * 256 * 128 / 2)]; dn[j] = dec[(size_t)(n0 + 16 + j) * (4 * 128 / 2)]; } }
#pragma unroll
            for (int j = 0; j < 16; ++j) { gst[(size_t)(n0 + j) * (4 * 256 * 128 / 2)] = cvt_pk_bf16(s0, s1);
                s0 = dc[j].x * s0 + bflo(u[j]); s1 = dc[j].y * s1 + bfhi(u[j]); }
        }
    } else if (gw < 1088) {
        const int g = gw - 1024;
        const f32x2 A = ((const f32x2*)(p.ws + WS_SA64))[g * 64 + lane];
        const f32x2* sc = (const f32x2*)(p.ws + WS_S5C) + (size_t)g * 64 + lane;
        f32x2* ss = (f32x2*)(p.ws + WS_S5S) + (size_t)g * 64 + lane;
        float sr = 0.f, si = 0.f;
        for (int n0 = 0; n0 < 256; n0 += 32) {
            f32x2 e[32];
#pragma unroll
            for (int j = 0; j < 32; ++j) e[j] = sc[(size_t)(n0 + j) * 4096];
#pragma unroll
            for (int j = 0; j < 32; ++j) { ss[(size_t)(n0 + j) * 4096] = (f32x2){sr, si};
                cplx_step(A, sr, si, e[j].x, e[j].y); }
        }
    }
}

constexpr int N_PHASES = 20;
__device__ __forceinline__ void run_phase(const Params& p, LAS unsigned char* lds, const int ph) {
    unsigned char* ws = p.ws;
    bf16_t* P = (bf16_t*)(ws + WS_P);
    bf16_t* HB = (bf16_t*)(ws + WS_HB);
    bf16_t* XB2 = (bf16_t*)(ws + WS_YA);
    float* RSS = (float*)(ws + WS_RSS);
    if (ph == 19) { phase_norm<false>(p.out, kin(24), nullptr, p.out); return; }
    const int l = (ph >= 10) ? 1 : 0, s = (ph >= 10) ? ph - 10 : ph;
    const int step = (l == 0) ? s : s + 1;
    const float* xin = (l == 0) ? kin(0) : p.out;
    switch (step) {
    case 0: {
        phase_conv<false>(p, 0, lds);
        phase_xb(kin(0), HB, RSS);
    } break;
    case 1: {
        pg8::Gemm g{HB, (const bf16_t*)(ws + WS_WIN), SEQ, NP, DM, DM};
        pg8::EpiProj E{P, RSS + (size_t)(l == 0 ? 0 : 2) * SEQ};
        pg8::gemm_phase(lds, g, E);
    } break;
    case 2: {
        for (int it = obid(); it < 512; it += gridDim.x) swa_item(P, (bf16_t*)(ws + WS_YA), (const float*)(ws + WS_ROPE), kin(13) + l * 16, it >> 2, it & 3, lds);
        for (int it = obid(); it < 1024; it += gridDim.x) gla_pass1_item(p, l, it >> 2, it & 3, lds);
        s5_pass<false>(p, l, lds);
    } break;
    case 3: phase_scan(p); phase_conv<true>(p, l, lds, 5); break;
    case 4: {
        for (int it = obid(); it < 1024; it += gridDim.x) gla_pass3_item(p, l, it >> 2, it & 3, lds);
        s5_pass<true>(p, l, lds);
    } break;
    case 5: {
        pg8::Gemm g{P + C_AQ, (const bf16_t*)(ws + WS_WGLU), SEQ, 1024, 1024, NP};
        pg8::EpiGlu E{P, kin(12) + (size_t)l * 1024};
        pg8::gemm_phase(lds, g, E);
    } break;
    case 6: {
        for (int br = 0; br < 3; ++br) {
            const bf16_t* A = (br == 0) ? P + C_GQ : (const bf16_t*)(ws + (br == 1 ? WS_YA : WS_YG));
            const bf16_t* W = (const bf16_t*)(ws + (br == 0 ? WS_WBS : (br == 1 ? WS_WBA : WS_WBG)));
            pg8::Gemm g{A, W, SEQ, DM, 1024, (br == 0) ? NP : 1024};
            pg8::EpiBranch E{P, HB, br};
            pg8::gemm_phase(lds, g, E);
        }
    } break;
    case 7: {
        pg8::Gemm g{HB, (const bf16_t*)(ws + WS_WOUT), SEQ, DM, DM, DM};
        pg8::EpiResid E{xin, p.out, XB2, RSS + (size_t)(l == 0 ? 1 : 3) * SEQ};
        pg8::gemm_phase(lds, g, E);
    } break;
    case 8: {
        if (l == 0) { __syncthreads(); phase_conv<false>(p, 1, lds); __syncthreads(); }
        pg8::Gemm g{XB2, (const bf16_t*)(ws + WS_WFF1), SEQ, DFF, DM, DM};
        pg8::EpiRelu2 E{P, RSS + (size_t)(l == 0 ? 1 : 3) * SEQ};
        pg8::gemm_phase(lds, g, E);
#ifdef PROBE_FFN1
        if (l == 1) pg8::gemm_phase(lds, g, E);
#endif
    } break;
    default: {
        pg8::Gemm g{P, (const bf16_t*)(ws + WS_WFF2), SEQ, DM, DFF, DFF};
        pg8::EpiResid E{p.out, p.out, (l == 0) ? HB : nullptr, (l == 0) ? RSS + (size_t)2 * SEQ : nullptr};
        pg8::gemm_phase(lds, g, E);
    } break;
    }
}


#define XB_XCNT(j)  (256  + 64 * (j))
#define XB_XSUB(j)  (1280 + 64 * (j))
#define XB_XGEN(j)  (2304 + 64 * (j))
#define XB_TOP      3328
#define XB_TOPGEN   3392
__device__ __forceinline__ unsigned xb_ld(unsigned* p)              { return __hip_atomic_load(p, __ATOMIC_RELAXED, __HIP_MEMORY_SCOPE_AGENT); }
__device__ __forceinline__ unsigned xb_add(unsigned* p, unsigned v) { return __hip_atomic_fetch_add(p, v, __ATOMIC_RELAXED, __HIP_MEMORY_SCOPE_AGENT); }
__device__ __forceinline__ unsigned xb_xcc_id() { return (unsigned)__builtin_amdgcn_s_getreg((3 << 11) | 20) & 0xFu; }
__device__ __forceinline__ void grid_barrier(unsigned* bar, const unsigned xcc, unsigned& nloc, unsigned& nx) {
    asm volatile("s_waitcnt vmcnt(0)" ::: "memory");
    __syncthreads();
    if (otid() == 0) {
        if (nloc == 0u) {
            const unsigned G = gridDim.x;
            for (;;) { unsigned sum = 0u, cnt = 0u, mine = 0u;
#pragma unroll
                for (unsigned j = 0; j < 16; ++j) { const unsigned c = xb_ld(&bar[XB_XCNT(j)]); sum += c; cnt += (c > 0u) ? 1u : 0u; mine = (j == xcc) ? c : mine; }
                if (sum == G) { nloc = mine; nx = cnt; break; }
                __builtin_amdgcn_s_sleep(1); } }
        const unsigned old = xb_add(&bar[XB_XSUB(xcc)], 1u);
        const unsigned gen = old / nloc;
        if (old + 1u == (gen + 1u) * nloc) {
            __builtin_amdgcn_fence(__ATOMIC_RELEASE, "agent");
            asm volatile("s_waitcnt vmcnt(0)" ::: "memory");
            const unsigned og = xb_add(&bar[XB_TOP], 1u);
            const unsigned tg = og / nx;
            if (og + 1u == (tg + 1u) * nx) xb_add(&bar[XB_TOPGEN], 1u);
            else while (xb_ld(&bar[XB_TOPGEN]) == tg) __builtin_amdgcn_s_sleep(1);
            __builtin_amdgcn_fence(__ATOMIC_ACQUIRE, "agent");
            xb_add(&bar[XB_XGEN(xcc)], 1u);
            asm volatile("s_waitcnt vmcnt(0)" ::: "memory");
        } else {
            while (xb_ld(&bar[XB_XGEN(xcc)]) == gen) __builtin_amdgcn_s_sleep(1);
            __builtin_amdgcn_fence(__ATOMIC_ACQUIRE, "agent");
            asm volatile("s_waitcnt vmcnt(0)" ::: "memory");
        }
    }
    __syncthreads();
}
#define MK_PHASE(k) if (p.ph_lo <= (k) && (k) < p.ph_hi) { if ((k) > p.ph_lo) { grid_barrier(xbar, xcc, xb_nloc, xb_nx); } run_phase(p, lds, (k)); }
__global__ void __launch_bounds__(512, 2) mega(Params p) {
    extern __shared__ __attribute__((aligned(16))) unsigned char shm_[];
    LAS unsigned char* lds = (LAS unsigned char*)shm_;
    unsigned* xbar = (unsigned*)(p.ws + WS_END);
    const unsigned xcc = xb_xcc_id();
    unsigned xb_nloc = 0u, xb_nx = 0u;
    if (p.ph_hi - p.ph_lo > 1 && otid() == 0) (void)xb_add(&xbar[XB_XCNT(xcc)], 1u);
    if (p.ph_lo < 0) cg::this_grid().sync();
    MK_PHASE(0) MK_PHASE(1) MK_PHASE(2) MK_PHASE(3) MK_PHASE(4) MK_PHASE(5) MK_PHASE(6) MK_PHASE(7) MK_PHASE(8) MK_PHASE(9) MK_PHASE(10)
    MK_PHASE(11) MK_PHASE(12) MK_PHASE(13) MK_PHASE(14) MK_PHASE(15) MK_PHASE(16) MK_PHASE(17) MK_PHASE(18) MK_PHASE(19)
    if (DBG_STOP >= 0 && !MK_LAUNCH_PER_PHASE) {
        cg::this_grid().sync();
        __builtin_amdgcn_fence(__ATOMIC_ACQUIRE, "agent");
        const unsigned* w = (const unsigned*)p.ws; const size_t nwords = WS_END / 4, nout = (size_t)SEQ * DM;
        for (size_t i = (size_t)obid() * 512 + otid(); i < nout; i += (size_t)gridDim.x * 512) {
            float s = 0.f;
            for (size_t j = i; j < nwords; j += nout) { const unsigned v = w[j]; s += (float)((v >> 16) ^ (v & 0xffffu)); }
            p.out[i] = s * (1.0f / 65536.0f);
        }
    }
}


__global__ void dbg_digest(const unsigned* w, float* out, size_t nwords, size_t nout) {
    for (size_t i = (size_t)blockIdx.x * blockDim.x + threadIdx.x; i < nout; i += (size_t)gridDim.x * blockDim.x) {
        float s = 0.f;
        for (size_t j = i; j < nwords; j += nout) { const unsigned v = w[j]; s += (float)((v >> 16) ^ (v & 0xffffu)); }
        out[i] = s * (1.0f / 65536.0f);
    }
}
extern "C" void kernel_launch(void* const* d_in, const int* in_sizes, int n_in, void* d_out, int out_size, void* d_ws, size_t ws_size, hipStream_t stream) {
    static int ready = 0;
    if (!ready) {
        if (n_in != 25 || out_size != SEQ * DM || ws_size < WS_TOTAL) { fprintf(stderr, "kernel_launch: unexpected shapes (n_in %d out %d ws %zu need %zu)\n", n_in, out_size, ws_size, (size_t)WS_END); ready = -1; return; }
        if (hipFuncSetAttribute((const void*)mega, hipFuncAttributeMaxDynamicSharedMemorySize, LDS_BYTES) != hipSuccess) { fprintf(stderr, "kernel_launch: hipFuncSetAttribute failed\n"); ready = -1; return; }
        ready = 1;
    }
    if (ready < 0) return;
    Params p{};
    for (int i = 0; i < 25; ++i) p.in[i] = (const float*)d_in[i];
    p.out = (float*)d_out; p.ws = (unsigned char*)d_ws;
#if MK_LAUNCH_PER_PHASE
    for (int ph = 0; ph < (DBG_STOP >= 0 ? DBG_STOP + 1 : N_PHASES); ++ph) {
        p.ph_lo = ph; p.ph_hi = ph + 1;
        hipLaunchKernelGGL(mega, dim3(256), dim3(512), LDS_BYTES, stream, p);
    }
    if (DBG_STOP >= 0) hipLaunchKernelGGL(dbg_digest, dim3(2048), dim3(256), 0, stream, (const unsigned*)d_ws, (float*)d_out, (size_t)(WS_END / 4), (size_t)SEQ * DM);
#else
    p.ph_lo = 0; p.ph_hi = (DBG_STOP >= 0) ? DBG_STOP + 1 : N_PHASES;
    hipMemsetAsync((unsigned char*)d_ws + WS_END, 0, WS_TOTAL - WS_END, stream);
    void* args[] = {&p};
    hipError_t e = hipLaunchCooperativeKernel((const void*)mega, dim3(256), dim3(512), args, LDS_BYTES, stream);
    if (e != hipSuccess) fprintf(stderr, "cooperative launch failed: %s\n", hipGetErrorString(e));
#endif
}
```
